# Optimizing an MI355X kernel written in HIP

```python
import math
import jax, jax.numpy as jnp
from jax import lax
import numpy as np

D_MODEL = 1024
BATCH = 2
SEQ = 8192
DEPTH = 2

GRID_W = 64
N_MEM = 256
D_MIX = D_MODEL
EPS = 1e-6

ATTN_HEADS = 8
ATTN_KV_HEADS = 2
ATTN_GROUP = ATTN_HEADS // ATTN_KV_HEADS
HEAD_DIM = 64
ATTN_W = ATTN_HEADS * HEAD_DIM
Q_BLOCK = 128
ROPE_THETA = 10000.0

CONV_CH = D_MIX // 4
CONV_WIDTH = 31

MLSTM_HEADS = 4
MLSTM_HEAD_DIM = 64
MLSTM_W = MLSTM_HEADS * MLSTM_HEAD_DIM
MLSTM_CHUNK = 128
N_DIRS = 2
N_GATES = N_DIRS * 2 * MLSTM_HEADS

XATTN_HEADS = 4
XATTN_HEAD_DIM = D_MODEL // XATTN_HEADS

D_FF = 2816

OFF_Q = 0
OFF_K = OFF_Q + ATTN_W
OFF_V = OFF_K + ATTN_KV_HEADS * HEAD_DIM
OFF_CONV = OFF_V + ATTN_KV_HEADS * HEAD_DIM
OFF_MQ = OFF_CONV + 2 * CONV_CH
OFF_MK = OFF_MQ + MLSTM_W
OFF_MV = OFF_MK + MLSTM_W
OFF_MO = OFF_MV + MLSTM_W
OFF_MG = OFF_MO + MLSTM_W
N_IN = OFF_MG + N_GATES

kernel_name = "hybrid_parallel_attn_conv_mlstm_encoder"


def rms_norm(x, g):
    xf = x.astype(jnp.float32)
    y = xf * lax.rsqrt(jnp.mean(xf * xf, axis=-1, keepdims=True) + EPS)
    return (y * g.astype(jnp.float32)).astype(x.dtype)


def swiglu_ffn(x, g, w13, w2):
    h = rms_norm(x, g)
    a, b = jnp.split(h @ w13, 2, axis=-1)
    return (jax.nn.silu(a) * b) @ w2


def axial_rope_table(seq_len):
    rows = seq_len // GRID_W
    row_idx = jnp.repeat(jnp.arange(rows, dtype=jnp.int32), GRID_W).astype(jnp.float32)
    col_idx = jnp.tile(jnp.arange(GRID_W, dtype=jnp.int32), rows).astype(jnp.float32)
    n_freq = HEAD_DIM // 4
    inv_freq = jnp.float32(ROPE_THETA) ** (-jnp.arange(n_freq, dtype=jnp.float32) / n_freq)
    ang = jnp.concatenate([row_idx[:, None] * inv_freq, col_idx[:, None] * inv_freq], axis=-1)
    return jnp.cos(ang), jnp.sin(ang)


def apply_rope(x, cos, sin):
    xf = x.astype(jnp.float32).reshape(x.shape[:-1] + (x.shape[-1] // 2, 2))
    x0, x1 = xf[..., 0], xf[..., 1]
    c = cos[None, :, None, :]
    s = sin[None, :, None, :]
    out = jnp.stack([x0 * c - x1 * s, x0 * s + x1 * c], axis=-1).reshape(x.shape)
    return out.astype(x.dtype)


def attention_group(hq, hk, hv, q_gain, k_gain, cos, sin):
    B, S, _ = hq.shape
    q = hq.reshape(B, S, ATTN_HEADS, HEAD_DIM)
    k = hk.reshape(B, S, ATTN_KV_HEADS, HEAD_DIM)
    v = hv.reshape(B, S, ATTN_KV_HEADS, HEAD_DIM)
    q = apply_rope(rms_norm(q, q_gain), cos, sin) * (HEAD_DIM ** -0.5)
    k = apply_rope(rms_norm(k, k_gain), cos, sin)
    nb = S // Q_BLOCK
    qb_all = q.reshape(B, nb, Q_BLOCK, ATTN_KV_HEADS, ATTN_GROUP, HEAD_DIM).transpose(1, 0, 2, 3, 4, 5)

    def one_block(qb):
        s = jnp.einsum('bqhgd,bkhd->bhgqk', qb, k, preferred_element_type=jnp.float32)
        p = jax.nn.softmax(s, axis=-1).astype(v.dtype)
        return jnp.einsum('bhgqk,bkhd->bqhgd', p, v)

    o = lax.map(one_block, qb_all)
    return o.transpose(1, 0, 2, 3, 4, 5).reshape(B, S, ATTN_W)


def conv_group(hc, dw_w, dw_b, ln_g, ln_b):
    a, gate = jnp.split(hc, 2, axis=-1)
    u = a * jax.nn.sigmoid(gate)
    pad = CONV_WIDTH // 2
    u = lax.conv_general_dilated(
        u, dw_w[:, None, :].astype(u.dtype), window_strides=(1,), padding=[(pad, pad)],
        dimension_numbers=('NWC', 'WIO', 'NWC'), feature_group_count=CONV_CH) + dw_b
    uf = u.astype(jnp.float32)
    mu = jnp.mean(uf, axis=-1, keepdims=True)
    var = jnp.mean(jnp.square(uf - mu), axis=-1, keepdims=True)
    un = (uf - mu) * lax.rsqrt(var + EPS) * ln_g.astype(jnp.float32) + ln_b.astype(jnp.float32)
    return jax.nn.silu(un).astype(hc.dtype)


def mlstm_scan(q, k, v, i_pre, log_f):
    B, S, H, D = q.shape
    L = MLSTM_CHUNK
    nc = S // L

    def chunk4(t):
        return t.reshape(B, nc, L, H, D).transpose(1, 0, 3, 2, 4)

    def chunk3(t):
        return t.reshape(B, nc, L, H).transpose(1, 0, 3, 2)

    mask = jnp.tril(jnp.ones((L, L), dtype=bool))
    neg_inf = jnp.float32(-jnp.inf)

    def step(carry, inp):
        C, n, m = carry
        qc, kc, vc, ic, fc = inp
        b = jnp.cumsum(fc, axis=-1)
        logw = b[..., :, None] - b[..., None, :] + ic[..., None, :]
        logw = jnp.where(mask, logw, neg_inf)
        m_inter = b + m[..., None]
        m_t = jnp.maximum(jnp.max(logw, axis=-1), m_inter)
        w = jnp.exp(logw - m_t[..., None])
        s = jnp.einsum('bhtd,bhsd->bhts', qc, kc) * w
        inter = jnp.exp(m_inter - m_t)
        num = jnp.einsum('bhts,bhsd->bhtd', s, vc) + inter[..., None] * jnp.einsum('bhed,bhtd->bhte', C, qc)
        den = jnp.sum(s, axis=-1) + inter * jnp.einsum('bhd,bhtd->bht', n, qc)
        h = num / jnp.maximum(jnp.abs(den), jnp.exp(-m_t))[..., None]
        b_end = b[..., -1]
        logw_end = b_end[..., None] - b + ic
        m_new = jnp.maximum(b_end + m, jnp.max(logw_end, axis=-1))
        w_end = jnp.exp(logw_end - m_new[..., None])
        decay = jnp.exp(b_end + m - m_new)
        C_new = decay[..., None, None] * C + jnp.einsum('bhs,bhse,bhsd->bhed', w_end, vc, kc)
        n_new = decay[..., None] * n + jnp.einsum('bhs,bhsd->bhd', w_end, kc)
        return (C_new, n_new, m_new), h

    init = (jnp.zeros((B, H, D, D), jnp.float32), jnp.zeros((B, H, D), jnp.float32),
            jnp.zeros((B, H), jnp.float32))
    _, hs = lax.scan(step, init, (chunk4(q), chunk4(k), chunk4(v), chunk3(i_pre), chunk3(log_f)))
    return hs.transpose(1, 0, 3, 2, 4).reshape(B, S, H, D)


def mlstm_group(hq, hk, hv, ho, hg, gate_b, out_gain):
    B, S, _ = hq.shape
    shp = (B, S, MLSTM_HEADS, MLSTM_HEAD_DIM)
    q = hq.reshape(shp).astype(jnp.float32)
    k = hk.reshape(shp).astype(jnp.float32) * (MLSTM_HEAD_DIM ** -0.5)
    v = hv.reshape(shp).astype(jnp.float32)
    g = hg.astype(jnp.float32).reshape(B, S, N_DIRS, 2, MLSTM_HEADS) + gate_b.astype(jnp.float32)
    i_pre = g[:, :, :, 0, :]
    log_f = jax.nn.log_sigmoid(g[:, :, :, 1, :])
    h_fwd = mlstm_scan(q, k, v, i_pre[:, :, 0], log_f[:, :, 0])
    rev = lambda t: jnp.flip(t, axis=1)
    h_bwd = rev(mlstm_scan(rev(q), rev(k), rev(v), rev(i_pre[:, :, 1]), rev(log_f[:, :, 1])))
    h = rms_norm(h_fwd + h_bwd, out_gain)
    return (jax.nn.sigmoid(ho.astype(jnp.float32)) * h.reshape(B, S, MLSTM_W)).astype(hq.dtype)


def memory_cross_attention(x, mem, x_gain, mem_gain, wq, wkv, q_gain, k_gain, wo):
    B, S, _ = x.shape
    M = mem.shape[1]
    q = (rms_norm(x, x_gain) @ wq).reshape(B, S, XATTN_HEADS, XATTN_HEAD_DIM)
    k, v = jnp.split(rms_norm(mem, mem_gain) @ wkv, 2, axis=-1)
    k = k.reshape(B, M, XATTN_HEADS, XATTN_HEAD_DIM)
    v = v.reshape(B, M, XATTN_HEADS, XATTN_HEAD_DIM)
    q = rms_norm(q, q_gain) * (XATTN_HEAD_DIM ** -0.5)
    k = rms_norm(k, k_gain)
    s = jnp.einsum('bqhd,bmhd->bhqm', q, k, preferred_element_type=jnp.float32)
    p = jax.nn.softmax(s, axis=-1).astype(v.dtype)
    o = jnp.einsum('bhqm,bmhd->bqhd', p, v).reshape(B, S, XATTN_HEADS * XATTN_HEAD_DIM)
    return o @ wo


def setup_inputs(seed: int = 0) -> dict:
    key = jax.random.key(seed)
    ks = iter(jax.random.split(key, 32))
    L = DEPTH

    def nrm(shape, scale):
        return jax.random.normal(next(ks), shape, jnp.float32) * scale

    def gain(shape):
        return 1.0 + nrm(shape, 0.02)

    x = nrm((BATCH, SEQ, D_MODEL), 1.0)
    mem = nrm((BATCH, N_MEM, D_MODEL), 1.0)
    ffn1_norm = gain((L, D_MODEL))
    ffn1_w13 = nrm((L, D_MODEL, 2 * D_FF), D_MODEL ** -0.5)
    ffn1_w2 = nrm((L, D_FF, D_MODEL), D_FF ** -0.5)
    mix_norm = gain((L, D_MODEL))
    w_in = nrm((L, D_MODEL, N_IN), D_MODEL ** -0.5)
    attn_q_norm = gain((L, HEAD_DIM))
    attn_k_norm = gain((L, HEAD_DIM))
    conv_dw_w = nrm((L, CONV_WIDTH, CONV_CH), CONV_WIDTH ** -0.5)
    conv_dw_b = nrm((L, CONV_CH), 0.02)
    conv_ln_g = gain((L, CONV_CH))
    conv_ln_b = nrm((L, CONV_CH), 0.02)
    i_bias = nrm((L, N_DIRS, 1, MLSTM_HEADS), 0.1)
    f_bias = jnp.linspace(3.0, 6.0, MLSTM_HEADS, dtype=jnp.float32) + nrm((L, N_DIRS, 1, MLSTM_HEADS), 0.1)
    mlstm_gate_b = jnp.concatenate([i_bias, f_bias], axis=2)
    mlstm_out_norm = gain((L, MLSTM_HEADS, MLSTM_HEAD_DIM))
    w_out = nrm((L, D_MIX, D_MODEL), D_MIX ** -0.5)
    xattn_norm = gain((L, D_MODEL))
    mem_norm = gain((L, D_MODEL))
    xattn_wq = nrm((L, D_MODEL, XATTN_HEADS * XATTN_HEAD_DIM), D_MODEL ** -0.5)
    xattn_wkv = nrm((L, D_MODEL, 2 * XATTN_HEADS * XATTN_HEAD_DIM), D_MODEL ** -0.5)
    xattn_q_norm = gain((L, XATTN_HEAD_DIM))
    xattn_k_norm = gain((L, XATTN_HEAD_DIM))
    xattn_wo = nrm((L, XATTN_HEADS * XATTN_HEAD_DIM, D_MODEL), (XATTN_HEADS * XATTN_HEAD_DIM) ** -0.5)
    ffn2_norm = gain((L, D_MODEL))
    ffn2_w13 = nrm((L, D_MODEL, 2 * D_FF), D_MODEL ** -0.5)
    ffn2_w2 = nrm((L, D_FF, D_MODEL), D_FF ** -0.5)
    return {
        "x": x, "mem": mem,
        "ffn1_norm": ffn1_norm, "ffn1_w13": ffn1_w13, "ffn1_w2": ffn1_w2,
        "mix_norm": mix_norm, "w_in": w_in,
        "attn_q_norm": attn_q_norm, "attn_k_norm": attn_k_norm,
        "conv_dw_w": conv_dw_w, "conv_dw_b": conv_dw_b, "conv_ln_g": conv_ln_g, "conv_ln_b": conv_ln_b,
        "mlstm_gate_b": mlstm_gate_b, "mlstm_out_norm": mlstm_out_norm,
        "w_out": w_out,
        "xattn_norm": xattn_norm, "mem_norm": mem_norm, "xattn_wq": xattn_wq, "xattn_wkv": xattn_wkv,
        "xattn_q_norm": xattn_q_norm, "xattn_k_norm": xattn_k_norm, "xattn_wo": xattn_wo,
        "ffn2_norm": ffn2_norm, "ffn2_w13": ffn2_w13, "ffn2_w2": ffn2_w2,
    }


def reference(x, mem, ffn1_norm, ffn1_w13, ffn1_w2, mix_norm, w_in, attn_q_norm, attn_k_norm,
              conv_dw_w, conv_dw_b, conv_ln_g, conv_ln_b, mlstm_gate_b, mlstm_out_norm, w_out,
              xattn_norm, mem_norm, xattn_wq, xattn_wkv, xattn_q_norm, xattn_k_norm, xattn_wo,
              ffn2_norm, ffn2_w13, ffn2_w2):
    cos, sin = axial_rope_table(x.shape[1])
    for l in range(DEPTH):
        x = x + 0.5 * swiglu_ffn(x, ffn1_norm[l], ffn1_w13[l], ffn1_w2[l])
        h = rms_norm(x, mix_norm[l]) @ w_in[l]
        y_attn = attention_group(h[..., OFF_Q:OFF_K], h[..., OFF_K:OFF_V], h[..., OFF_V:OFF_CONV],
                                 attn_q_norm[l], attn_k_norm[l], cos, sin)
        y_conv = conv_group(h[..., OFF_CONV:OFF_MQ], conv_dw_w[l], conv_dw_b[l], conv_ln_g[l], conv_ln_b[l])
        y_mlstm = mlstm_group(h[..., OFF_MQ:OFF_MK], h[..., OFF_MK:OFF_MV], h[..., OFF_MV:OFF_MO],
                              h[..., OFF_MO:OFF_MG], h[..., OFF_MG:N_IN], mlstm_gate_b[l], mlstm_out_norm[l])
        x = x + jnp.concatenate([y_attn, y_conv, y_mlstm], axis=-1) @ w_out[l]
        x = x + memory_cross_attention(x, mem, xattn_norm[l], mem_norm[l], xattn_wq[l], xattn_wkv[l],
                                       xattn_q_norm[l], xattn_k_norm[l], xattn_wo[l])
        x = x + 0.5 * swiglu_ffn(x, ffn2_norm[l], ffn2_w13[l], ffn2_w2[l])
    return x
```

```cpp
#include <hip/hip_runtime.h>
#include <hip/hip_cooperative_groups.h>
#include <hip/hip_bf16.h>
#include <cstdio>
#include <cstdint>
#include <cmath>
namespace cg = cooperative_groups;
#define LAS __attribute__((address_space(3)))
namespace pg8 {
#define PG8_LAS __attribute__((address_space(3)))
typedef unsigned short bf16_t;
typedef short bf16x8 __attribute__((ext_vector_type(8)));
typedef float f32x4 __attribute__((ext_vector_type(4)));
typedef unsigned u32x4 __attribute__((ext_vector_type(4)));
constexpr int BM = 256, BK = 64, HALF = 128, HTB = HALF * BK * 2  , STAGE_BYTES = 8 * HTB, NXCD = 8, WGM = 8;

__host__ __device__ __forceinline__ int lds_byte(int r, int c) { const int st = (r >> 4) * 2 + (c >> 5), rr = r & 15, cc = c & 31, ob = rr * 64 + cc * 2; return st * 1024 + (ob ^ (((ob >> 9) & 1) << 5)); }
__host__ __device__ __forceinline__ void stage_rc(int b, int& R, int& C) { const int st = b / 1024, sb = b % 1024, swz = sb ^ (((sb >> 9) & 1) << 5); R = (st >> 1) * 16 + swz / 64; C = (st & 1) * 32 + (swz % 64) / 2; }
__host__ __device__ __forceinline__ int perm32(int rho) { const int n = rho >> 4, i = rho & 15; return 8 * (i >> 2) + 4 * n + (i & 3); }

struct Unit { int pm, pn; };
struct Gemm { const bf16_t* A; const bf16_t* Bt; int M, N, K; };

struct StaticOrder {
    int nM, nN, nwg, G, c;
    __host__ __device__ void init(int M, int N, int G_, int c_) { nM = M / BM; nN = N / BM; nwg = nM * nN; G = G_; c = c_; }
    __host__ __device__ bool next(int i, Unit& u) const {
        const long L = (long)i * G + c; if (L >= nwg) return false;
        int wgid = (int)L; { const int q = nwg / NXCD, r = nwg % NXCD, xcd = wgid % NXCD, off = wgid / NXCD; wgid = (xcd < r ? xcd * (q + 1) : r * (q + 1) + (xcd - r) * q) + off; }
        const int nig = WGM * nN, gid = wgid / nig, fm = gid * WGM, gsz = (nM - fm) < WGM ? (nM - fm) : WGM;
        u.pm = fm + ((wgid % nig) % gsz); u.pn = (wgid % nig) / gsz; return true;
    }
    __device__ __forceinline__ void a_ready(const Unit&) const {}
    __device__ __forceinline__ void done(const Unit&) const {}
};

__device__ __forceinline__ unsigned cvt_pk_bf16(float lo, float hi) { unsigned r; asm volatile("v_cvt_pk_bf16_f32 %0, %1, %2" : "=v"(r) : "v"(lo), "v"(hi)); return r; }
__device__ __forceinline__ float silu_f(float a) { return a * __builtin_amdgcn_rcpf(1.0f + __expf(-a)); }

__device__ __forceinline__ float row_rstd(const float* SS, int row) {
    const f32x4* p = (const f32x4*)(SS + (size_t)row * 16); const f32x4 a = p[0], b = p[1], c = p[2], d = p[3];
    const float s = ((a[0] + a[1]) + (a[2] + a[3])) + ((b[0] + b[1]) + (b[2] + b[3])) + ((c[0] + c[1]) + (c[2] + c[3])) + ((d[0] + d[1]) + (d[2] + d[3]));
    return __builtin_amdgcn_rsqf(s * (1.0f / 1024.0f) + 1e-6f);
}
#define ROW_RSTD8(rs, SS, row0, fq) do { f32x4 part_[2][4]; \
    _Pragma("unroll") for (int ai_ = 0; ai_ < 2; ++ai_) _Pragma("unroll") for (int m_ = 0; m_ < 4; ++m_) part_[ai_][m_] = *(const f32x4*)((SS) + (size_t)((row0) + ai_ * HALF + m_ * 16) * 16 + 4 * (fq)); \
    _Pragma("unroll") for (int ai_ = 0; ai_ < 2; ++ai_) _Pragma("unroll") for (int m_ = 0; m_ < 4; ++m_) { float s_ = (part_[ai_][m_][0] + part_[ai_][m_][1]) + (part_[ai_][m_][2] + part_[ai_][m_][3]); \
        s_ += __shfl_xor(s_, 16); s_ += __shfl_xor(s_, 32); rs[ai_][m_] = __builtin_amdgcn_rsqf(s_ * (1.0f / 1024.0f) + 1e-6f); } } while (0)
struct EpiStoreBf16 {
    static constexpr bool PERM = true, AFTER_DRAIN = false;
    bf16_t* O; int ldc; float* gates; const PG8_LAS float* RS; mutable int ui;
    __device__ __forceinline__ void operator()(const f32x4 (&acc)[2][2][4][2], const Unit& u, int wr, int wc, int fr, int fq) const {
        const int row0 = u.pm * BM + wr * 64 + fr, col0 = u.pn * BM + wc * 32 + 8 * fq;
        float rsv[2][4];
#pragma unroll
        for (int ai = 0; ai < 2; ++ai)
#pragma unroll
            for (int m = 0; m < 4; ++m) rsv[ai][m] = RS[ui * 256 + ai * HALF + wr * 64 + m * 16 + fr];
        ++ui;
#pragma unroll
        for (int ai = 0; ai < 2; ++ai)
#pragma unroll
            for (int m = 0; m < 4; ++m) { const int row = row0 + ai * HALF + m * 16; bf16_t* rowp = O + (size_t)row * ldc + col0; const float rs = rsv[ai][m];
#pragma unroll
                for (int bj = 0; bj < 2; ++bj) { const f32x4 v0 = acc[ai][bj][m][0] * rs, v1 = acc[ai][bj][m][1] * rs;
                    u32x4 w; w.x = cvt_pk_bf16(v0[0], v0[1]); w.y = cvt_pk_bf16(v0[2], v0[3]); w.z = cvt_pk_bf16(v1[0], v1[1]); w.w = cvt_pk_bf16(v1[2], v1[3]);
                    *(u32x4*)(rowp + bj * HALF) = w; }
                if (gates != nullptr && u.pn == 9 && wc == 0 && fq < 2) { float* gp = gates + (size_t)row * 16 + 8 * fq; *(f32x4*)gp = acc[ai][0][m][0] * rs; *(f32x4*)(gp + 4) = acc[ai][0][m][1] * rs; }
            }
    }
};
struct EpiSwiGLU {
    static constexpr bool PERM = true, AFTER_DRAIN = false;
    bf16_t* H; int ldh; const PG8_LAS float* RS; mutable int ui;
    __device__ __forceinline__ void operator()(const f32x4 (&acc)[2][2][4][2], const Unit& u, int wr, int wc, int fr, int fq) const {
        const int row0 = u.pm * BM + wr * 64 + fr, col0 = u.pn * HALF + wc * 32 + 8 * fq;
        float rsv[2][4];
#pragma unroll
        for (int ai = 0; ai < 2; ++ai)
#pragma unroll
            for (int m = 0; m < 4; ++m) rsv[ai][m] = RS[ui * 256 + ai * HALF + wr * 64 + m * 16 + fr];
        ++ui;
#pragma unroll
        for (int ai = 0; ai < 2; ++ai)
#pragma unroll
            for (int m = 0; m < 4; ++m) { const int row = row0 + ai * HALF + m * 16; bf16_t* rowp = H + (size_t)row * ldh + col0; const float rs = rsv[ai][m];
                const float rs2 = rs * -1.4426950408889634f, rsq = rs * rs;
                f32x4 o0, o1;
                {   const f32x4 a = acc[ai][0][m][0], b = acc[ai][1][m][0]; const f32x4 t = a * rs2; f32x4 ex;
                    ex[0] = __builtin_amdgcn_exp2f(t[0]); ex[1] = __builtin_amdgcn_exp2f(t[1]); ex[2] = __builtin_amdgcn_exp2f(t[2]); ex[3] = __builtin_amdgcn_exp2f(t[3]);
                    const f32x4 d = ex + 1.0f; f32x4 r; r[0] = __builtin_amdgcn_rcpf(d[0]); r[1] = __builtin_amdgcn_rcpf(d[1]); r[2] = __builtin_amdgcn_rcpf(d[2]); r[3] = __builtin_amdgcn_rcpf(d[3]);
                    o0 = (a * b) * (r * rsq); }
                {   const f32x4 a = acc[ai][0][m][1], b = acc[ai][1][m][1]; const f32x4 t = a * rs2; f32x4 ex;
                    ex[0] = __builtin_amdgcn_exp2f(t[0]); ex[1] = __builtin_amdgcn_exp2f(t[1]); ex[2] = __builtin_amdgcn_exp2f(t[2]); ex[3] = __builtin_amdgcn_exp2f(t[3]);
                    const f32x4 d = ex + 1.0f; f32x4 r; r[0] = __builtin_amdgcn_rcpf(d[0]); r[1] = __builtin_amdgcn_rcpf(d[1]); r[2] = __builtin_amdgcn_rcpf(d[2]); r[3] = __builtin_amdgcn_rcpf(d[3]);
                    o1 = (a * b) * (r * rsq); }
                u32x4 w; w.x = cvt_pk_bf16(o0[0], o0[1]); w.y = cvt_pk_bf16(o0[2], o0[3]); w.z = cvt_pk_bf16(o1[0], o1[1]); w.w = cvt_pk_bf16(o1[2], o1[3]);
                *(u32x4*)rowp = w; }
    }
};
struct EpiResid {
    static constexpr bool PERM = true, AFTER_DRAIN = false;
    const float* base; float* out; int ldc; float scale; bf16_t* XB; float* SS;
    __device__ __forceinline__ void operator()(const f32x4 (&acc)[2][2][4][2], const Unit& u, int wr, int wc, int fr, int fq) const {
        const int row0 = u.pm * BM + wr * 64 + fr, col0 = u.pn * BM + wc * 32 + 8 * fq;
        f32x4 xq[2][2][2][2];
#define EPR_LOAD(g_) do { _Pragma("unroll") for (int mm = 0; mm < 2; ++mm) { const size_t off_ = (size_t)(row0 + ((g_) >> 1) * HALF + (((g_) & 1) * 2 + mm) * 16) * ldc + col0; \
            _Pragma("unroll") for (int bj = 0; bj < 2; ++bj) { xq[(g_) & 1][mm][bj][0] = *(const f32x4*)(base + off_ + bj * HALF); xq[(g_) & 1][mm][bj][1] = *(const f32x4*)(base + off_ + bj * HALF + 4); } } } while (0)
        EPR_LOAD(0);
#pragma unroll
        for (int h8 = 0; h8 < 4; ++h8) { const int ai = h8 >> 1, m0 = (h8 & 1) * 2;
            if (h8 < 3) EPR_LOAD(h8 + 1);
            __builtin_amdgcn_sched_barrier(0);
#pragma unroll
            for (int mm = 0; mm < 2; ++mm) { const int m = m0 + mm; const int row = row0 + ai * HALF + m * 16; const size_t off = (size_t)row * ldc + col0; float ss = 0.f;
#pragma unroll
                for (int bj = 0; bj < 2; ++bj) {
                    const f32x4 x0 = xq[h8 & 1][mm][bj][0] + acc[ai][bj][m][0] * scale, x1 = xq[h8 & 1][mm][bj][1] + acc[ai][bj][m][1] * scale;
                    *(f32x4*)(out + off + bj * HALF) = x0; *(f32x4*)(out + off + bj * HALF + 4) = x1;
                    ss += ((x0[0] * x0[0] + x0[1] * x0[1]) + (x0[2] * x0[2] + x0[3] * x0[3])) + ((x1[0] * x1[0] + x1[1] * x1[1]) + (x1[2] * x1[2] + x1[3] * x1[3]));
                    u32x4 w; w.x = cvt_pk_bf16(x0[0], x0[1]); w.y = cvt_pk_bf16(x0[2], x0[3]); w.z = cvt_pk_bf16(x1[0], x1[1]); w.w = cvt_pk_bf16(x1[2], x1[3]);
                    *(u32x4*)(XB + off + bj * HALF) = w; }
                ss += __shfl_xor(ss, 16); ss += __shfl_xor(ss, 32);
                if (fq == 0) SS[(size_t)row * 16 + u.pn * 4 + wc] = ss; }
        }
#undef EPR_LOAD
    }
};
struct EpiF32 {
    static constexpr bool PERM = true, AFTER_DRAIN = false;
    float* out; int ldc;
    __device__ __forceinline__ void operator()(const f32x4 (&acc)[2][2][4][2], const Unit& u, int wr, int wc, int fr, int fq) const {
        const int row0 = u.pm * BM + wr * 64 + fr, col0 = u.pn * BM + wc * 32 + 8 * fq;
#pragma unroll
        for (int ai = 0; ai < 2; ++ai)
#pragma unroll
            for (int m = 0; m < 4; ++m) { const size_t off = (size_t)(row0 + ai * HALF + m * 16) * ldc + col0;
#pragma unroll
                for (int bj = 0; bj < 2; ++bj) { *(f32x4*)(out + off + bj * HALF) = acc[ai][bj][m][0]; *(f32x4*)(out + off + bj * HALF + 4) = acc[ai][bj][m][1]; } }
    }
};
template <class Epi, class Sched, bool ALIGN_EPI = false, bool SP2 = false>
__device__ __forceinline__ void gemm_phase(PG8_LAS unsigned char* lds, const Gemm g, const Sched& S, const Epi& E) {
    int tid_l = threadIdx.x; asm volatile("" : "+v"(tid_l)); const int tid = tid_l, wid = __builtin_amdgcn_readfirstlane(tid >> 6), lane = tid & 63, wr = wid >> 2, wc = wid & 3, fr = lane & 15, fq = lane >> 4;
    const int K = g.K, nt = K / BK;
    unsigned voffA[2], voffB[2];
#pragma unroll
    for (int i = 0; i < 2; ++i) { int R, C; stage_rc(tid * 16 + i * 8192, R, C); const int Rb = Epi::PERM ? ((R & ~31) + perm32(R & 31)) : R;
        voffA[i] = (unsigned)(R * K + C) * 2u; voffB[i] = (unsigned)(Rb * K + C) * 2u; }
    const size_t kstep = (size_t)(BK * 2);
    const size_t hstep = (size_t)HALF * K * 2;
    const size_t tstep = 2 * hstep;
    const unsigned ldsw = (unsigned)wid * 1024u;
    const int aoff = lds_byte(wr * 64 + fr, fq * 8), boff = lds_byte(wc * 32 + fr, fq * 8);
#define PG8_SA(b, h) (((b) * 2 + (h)) * HTB)
#define PG8_SB(b, h) ((4 + (b) * 2 + (h)) * HTB)
#define PG8_STAGE(bufoff, gbase, voff) do { _Pragma("unroll") for (int _i = 0; _i < 2; ++_i) \
        __builtin_amdgcn_global_load_lds((const unsigned*)((const char*)(gbase) + (voff)[_i]), (PG8_LAS unsigned*)(lds + (bufoff) + ldsw + _i * 8192), 16, 0, 0); } while (0)
#define PG8_LDA(dst, b, h) do { _Pragma("unroll") for (int m = 0; m < 4; ++m) _Pragma("unroll") for (int k = 0; k < 2; ++k) dst[m][k] = *(const PG8_LAS bf16x8*)(lds + PG8_SA(b, h) + aoff + m * 2048 + k * 1024); } while (0)
#define PG8_LDB(dst, b, h) do { _Pragma("unroll") for (int n = 0; n < 2; ++n) _Pragma("unroll") for (int k = 0; k < 2; ++k) dst[n][k] = *(const PG8_LAS bf16x8*)(lds + PG8_SB(b, h) + boff + n * 2048 + k * 1024); } while (0)
#define PG8_MMA(ai, bj, At, Bt) do { __builtin_amdgcn_s_setprio(1); _Pragma("unroll") for (int m = 0; m < 4; ++m) _Pragma("unroll") for (int n = 0; n < 2; ++n) _Pragma("unroll") for (int k = 0; k < 2; ++k) \
        acc[ai][bj][m][n] = __builtin_amdgcn_mfma_f32_16x16x32_bf16(Bt[n][k], At[m][k], acc[ai][bj][m][n], 0, 0, 0); __builtin_amdgcn_s_setprio(0); } while (0)
#define PG8_WAIT_V(n) asm volatile("s_waitcnt vmcnt(" #n ")" ::: "memory")
#define PG8_WAIT_L(n) asm volatile("s_waitcnt lgkmcnt(" #n ")" ::: "memory")
#define PG8_BAR __builtin_amdgcn_s_barrier()
#define PG8_SCHED __builtin_amdgcn_sched_barrier(0)
    Unit cur, nxt; int ui = 0;
    if (!S.next(0, cur)) return;
    f32x4 acc[2][2][4][2];
#pragma unroll
    for (int a = 0; a < 2; ++a)
#pragma unroll
        for (int b = 0; b < 2; ++b)
#pragma unroll
            for (int m = 0; m < 4; ++m)
#pragma unroll
                for (int n = 0; n < 2; ++n) acc[a][b][m][n] = (f32x4){0.f, 0.f, 0.f, 0.f};
    bf16x8 At[4][2], B0[2][2], B1[2][2];
    const char* cA = (const char*)g.A + (size_t)cur.pm * tstep; const char* cB = (const char*)g.Bt + (size_t)cur.pn * tstep;
    S.a_ready(cur);
    if constexpr (SP2) {
        PG8_STAGE(PG8_SB(0, 0), cB, voffB); PG8_STAGE(PG8_SB(0, 1), cB + hstep, voffB); PG8_STAGE(PG8_SA(0, 0), cA, voffA); PG8_STAGE(PG8_SA(0, 1), cA + hstep, voffA);
        if (wr == 1) PG8_BAR;
        PG8_WAIT_V(2); PG8_BAR;
        PG8_STAGE(PG8_SB(1, 0), cB + kstep, voffB); PG8_STAGE(PG8_SA(1, 0), cA + kstep, voffA); PG8_STAGE(PG8_SB(1, 1), cB + hstep + kstep, voffB);
        PG8_WAIT_V(6); PG8_BAR;
    } else {
        PG8_STAGE(PG8_SB(0, 0), cB, voffB); PG8_STAGE(PG8_SA(0, 0), cA, voffA); PG8_STAGE(PG8_SB(0, 1), cB + hstep, voffB); PG8_STAGE(PG8_SA(0, 1), cA + hstep, voffA);
        if (wr == 1) PG8_BAR;
        PG8_WAIT_V(4); PG8_BAR;
        PG8_STAGE(PG8_SB(1, 0), cB + kstep, voffB); PG8_STAGE(PG8_SA(1, 0), cA + kstep, voffA); PG8_STAGE(PG8_SB(1, 1), cB + hstep + kstep, voffB);
        PG8_WAIT_V(6); PG8_BAR;
    }
    for (;;) {
        const bool has_next = S.next(ui + 1, nxt);
        const char* nA = has_next ? (const char*)g.A + (size_t)nxt.pm * tstep : cA; const char* nB = has_next ? (const char*)g.Bt + (size_t)nxt.pn * tstep : cB;
        for (int t = 0; t < nt; t += 2) {
            const bool last = (t == nt - 2);
            const char* a1 = cA + (size_t)(t + 1) * kstep;
            const char* a2 = last ? nA : cA + (size_t)(t + 2) * kstep; const char* b2 = last ? nB : cB + (size_t)(t + 2) * kstep;
            const char* a3 = a2 + kstep; const char* b3 = b2 + kstep;
            if (last && has_next) S.a_ready(nxt);
            if constexpr (SP2) {
            PG8_LDB(B0, 0, 0); PG8_LDB(B1, 0, 1); PG8_SCHED; PG8_LDA(At, 0, 0); PG8_STAGE(PG8_SA(1, 1), a1 + hstep, voffA);
            PG8_WAIT_V(8); PG8_WAIT_L(0); PG8_BAR; PG8_MMA(0, 0, At, B0); PG8_MMA(0, 1, At, B1); PG8_BAR; PG8_SCHED;
            PG8_LDA(At, 0, 1); PG8_STAGE(PG8_SB(0, 0), b2, voffB); PG8_STAGE(PG8_SB(0, 1), b2 + hstep, voffB); PG8_STAGE(PG8_SA(0, 0), a2, voffA);
            PG8_WAIT_V(8); PG8_WAIT_L(0); PG8_BAR; PG8_MMA(1, 0, At, B0); PG8_MMA(1, 1, At, B1); PG8_BAR; PG8_SCHED;
            PG8_LDB(B0, 1, 0); PG8_LDB(B1, 1, 1); PG8_SCHED; PG8_LDA(At, 1, 0); PG8_STAGE(PG8_SA(0, 1), a2 + hstep, voffA);
            PG8_WAIT_V(8); PG8_WAIT_L(0); PG8_BAR; PG8_MMA(0, 0, At, B0); PG8_MMA(0, 1, At, B1); PG8_BAR; PG8_SCHED;
            PG8_LDA(At, 1, 1); PG8_STAGE(PG8_SB(1, 0), b3, voffB); PG8_STAGE(PG8_SB(1, 1), b3 + hstep, voffB); PG8_STAGE(PG8_SA(1, 0), a3, voffA);
            PG8_WAIT_V(8); PG8_WAIT_L(0); PG8_BAR; PG8_MMA(1, 0, At, B0); PG8_MMA(1, 1, At, B1); PG8_BAR; PG8_SCHED;
            } else {
            PG8_LDB(B0, 0, 0); PG8_SCHED; PG8_LDA(At, 0, 0); PG8_STAGE(PG8_SA(1, 1), a1 + hstep, voffA);
            PG8_WAIT_L(8); PG8_BAR; PG8_WAIT_L(0); PG8_MMA(0, 0, At, B0); PG8_BAR; PG8_SCHED;
            PG8_LDB(B1, 0, 1); PG8_STAGE(PG8_SB(0, 0), b2, voffB);
            PG8_BAR; PG8_WAIT_L(0); PG8_MMA(0, 1, At, B1); PG8_BAR;
            PG8_LDA(At, 0, 1); PG8_STAGE(PG8_SA(0, 0), a2, voffA);
            PG8_BAR; PG8_WAIT_L(0); PG8_MMA(1, 0, At, B0); PG8_BAR; PG8_SCHED;
            PG8_STAGE(PG8_SB(0, 1), b2 + hstep, voffB);
            PG8_WAIT_V(6); PG8_BAR; PG8_MMA(1, 1, At, B1); PG8_BAR;
            PG8_LDB(B0, 1, 0); PG8_SCHED; PG8_LDA(At, 1, 0); PG8_STAGE(PG8_SA(0, 1), a2 + hstep, voffA);
            PG8_WAIT_L(8); PG8_BAR; PG8_WAIT_L(0); PG8_MMA(0, 0, At, B0); PG8_BAR; PG8_SCHED;
            PG8_LDB(B1, 1, 1); PG8_STAGE(PG8_SB(1, 0), b3, voffB);
            PG8_BAR; PG8_WAIT_L(0); PG8_MMA(0, 1, At, B1); PG8_BAR;
            PG8_LDA(At, 1, 1); PG8_STAGE(PG8_SA(1, 0), a3, voffA);
            PG8_BAR; PG8_WAIT_L(0); PG8_MMA(1, 0, At, B0); PG8_BAR; PG8_SCHED;
            PG8_STAGE(PG8_SB(1, 1), b3 + hstep, voffB);
            PG8_WAIT_V(6); PG8_BAR; PG8_MMA(1, 1, At, B1); PG8_BAR;
            }
        }
        if constexpr (ALIGN_EPI) { if (wr == 0) PG8_BAR; }
        if constexpr (!Epi::AFTER_DRAIN) { E(acc, cur, wr, wc, fr, fq); S.done(cur); }
        if (!has_next) break;
#pragma unroll
        for (int a = 0; a < 2; ++a)
#pragma unroll
            for (int b = 0; b < 2; ++b)
#pragma unroll
                for (int m = 0; m < 4; ++m)
#pragma unroll
                    for (int n = 0; n < 2; ++n) acc[a][b][m][n] = (f32x4){0.f, 0.f, 0.f, 0.f};
        cur = nxt; cA = nA; cB = nB; ++ui;
        if constexpr (ALIGN_EPI) { if (wr == 1) PG8_BAR; }
    }
    PG8_WAIT_V(0);
    if constexpr (!ALIGN_EPI) { if (wr == 0) PG8_BAR; }
    PG8_BAR;
    if constexpr (Epi::AFTER_DRAIN) { E.fused(acc, cur, wr, wc, fr, fq, lds, wid, lane); S.done(cur); }
#undef PG8_SA
#undef PG8_SB
#undef PG8_STAGE
#undef PG8_LDA
#undef PG8_LDB
#undef PG8_MMA
#undef PG8_WAIT_V
#undef PG8_WAIT_L
#undef PG8_BAR
#undef PG8_SCHED
}
}
namespace attn_body {
using bf16=__hip_bfloat16;
using bf16x8=__attribute__((ext_vector_type(8)))short;
using s16x4=__attribute__((ext_vector_type(4)))short;
using f32x16=__attribute__((ext_vector_type(16)))float;
using u32x4=__attribute__((ext_vector_type(4)))unsigned;
using f32x4q=__attribute__((ext_vector_type(4)))float;
constexpr int SEQ=8192,D=64,QP=2560,KP=2560,OP=1024;
constexpr int NW=8,QBLK=32,QB=QBLK*NW,KVBLK=64,NQB=SEQ/QB;
constexpr int ATTN_UNIT_ROWS=QB;
__device__ __forceinline__ int crow(int r,int hi){return (r&3)+8*(r>>2)+4*hi;}
#define SBAR() __builtin_amdgcn_sched_barrier(0)
__device__ __forceinline__ void cmask(f32x16&p0,f32x16&p1,int jb,int qrel,int hi){
  const float NEG=-INFINITY; int kb=64*jb+4*hi;
  #pragma unroll
  for(int r=0;r<16;++r){int kv=kb+(r&3)+8*(r>>2); if(kv>qrel)p0[r]=NEG; if(kv+32>qrel)p1[r]=NEG;}
}

constexpr int NSLOT=3, SLOTB=8192;
constexpr int LDS_K=0, LDS_V=NSLOT*SLOTB, LDS_WS=2*NSLOT*SLOTB, LDS_OST=LDS_WS+NW*64*4, LDS_BYTES=LDS_OST+NW*4096;
constexpr float C2=0.125f*1.4426950408889634f;
__device__ __forceinline__ void glds16(const void*gsrc,unsigned lds_dst){unsigned keep;
  asm volatile("s_mov_b32 %0, m0\n\ts_mov_b32 m0, %2\n\ts_nop 0\n\tglobal_load_lds_dwordx4 %1, off\n\ts_mov_b32 m0, %0":"=&s"(keep):"v"(gsrc),"s"(lds_dst):"memory");}
__device__ __forceinline__ float max3f(float a,float b,float c){float r;asm("v_max3_f32 %0, %1, %2, %3":"=v"(r):"v"(a),"v"(b),"v"(c));return r;}
__device__ __forceinline__ float max2f(float a,float b){float r;asm("v_max_f32_e32 %0, %1, %2":"=v"(r):"v"(a),"v"(b));return r;}
__device__ __forceinline__ float fadd_s(float a,float b){float r;asm("v_add_f32_e32 %0, %1, %2":"=v"(r):"v"(a),"v"(b));return r;}
__device__ __forceinline__ float fsub_s(float a,float b){float r;asm("v_sub_f32_e32 %0, %1, %2":"=v"(r):"v"(a),"v"(b));return r;}
typedef float f32x2_t __attribute__((ext_vector_type(2))); typedef __bf16 bf16x2_t __attribute__((ext_vector_type(2)));
__device__ __forceinline__ unsigned cvtpk_s(float lo,float hi){f32x2_t v={lo,hi};bf16x2_t b=__builtin_convertvector(v,bf16x2_t);return __builtin_bit_cast(unsigned,b);}
#define WAIT_BAR(N) asm volatile("s_waitcnt vmcnt(" #N ") lgkmcnt(0)\n\ts_barrier":::"memory")

__device__ __forceinline__ void qkt(f32x16&p0,f32x16&p1,const char*Kslot,const bf16x8*qr,const f32x16&negm,int r32,int hi){
  const char*kb=Kslot+hi*1024+r32*16;
  #pragma unroll
  for(int d0=0;d0<4;++d0){
    const bf16x8 b0=*reinterpret_cast<const bf16x8*>(kb+d0*2048);
    const bf16x8 b1=*reinterpret_cast<const bf16x8*>(kb+d0*2048+512);
    if(d0==0){p0=__builtin_amdgcn_mfma_f32_32x32x16_bf16(b0,qr[0],negm,0,0,0);p1=__builtin_amdgcn_mfma_f32_32x32x16_bf16(b1,qr[0],negm,0,0,0);}
    else{p0=__builtin_amdgcn_mfma_f32_32x32x16_bf16(b0,qr[d0],p0,0,0,0);p1=__builtin_amdgcn_mfma_f32_32x32x16_bf16(b1,qr[d0],p1,0,0,0);}}
}
typedef __attribute__((address_space(3))) const char* lds_cptr;
typedef short v4i16_t __attribute__((ext_vector_type(4)));
__device__ __forceinline__ void kload8(bf16x8*kf,lds_cptr kp){
  kf[0]=*(const __attribute__((address_space(3))) bf16x8*)(kp);      kf[1]=*(const __attribute__((address_space(3))) bf16x8*)(kp+512);
  kf[2]=*(const __attribute__((address_space(3))) bf16x8*)(kp+2048); kf[3]=*(const __attribute__((address_space(3))) bf16x8*)(kp+2560);
  kf[4]=*(const __attribute__((address_space(3))) bf16x8*)(kp+4096); kf[5]=*(const __attribute__((address_space(3))) bf16x8*)(kp+4608);
  kf[6]=*(const __attribute__((address_space(3))) bf16x8*)(kp+6144); kf[7]=*(const __attribute__((address_space(3))) bf16x8*)(kp+6656);
}
__device__ __forceinline__ void kload2(bf16x8*kf,lds_cptr kp,int j){ kf[2*j]=*(const __attribute__((address_space(3))) bf16x8*)(kp+j*2048); kf[2*j+1]=*(const __attribute__((address_space(3))) bf16x8*)(kp+j*2048+512); }
__device__ __forceinline__ s16x4 vtr(lds_cptr p){ return __builtin_bit_cast(s16x4,__builtin_amdgcn_ds_read_tr16_b64_v4i16((__attribute__((address_space(3))) v4i16_t*)p)); }
__device__ __forceinline__ float rowmax(const f32x16&p0,const f32x16&p1){
  float a=max3f(p0[0],p0[1],p1[0]),b=max3f(p0[2],p0[3],p1[1]);a=max3f(a,p1[2],p1[3]);
  #pragma unroll
  for(int r=4;r<16;r+=4){a=max3f(a,p0[r],p0[r+1]);b=max3f(b,p0[r+2],p0[r+3]);a=max3f(a,p1[r],p1[r+1]);b=max3f(b,p1[r+2],p1[r+3]);}
  const float m=max2f(a,b);
  auto rr=__builtin_amdgcn_permlane32_swap(__float_as_uint(m),__float_as_uint(m),false,false);
  return max2f(__uint_as_float(rr[0]),__uint_as_float(rr[1]));
}
__device__ __forceinline__ void pv(f32x16*o,int vb,bf16x8 pa0,bf16x8 pa1,bf16x8 pa2,bf16x8 pa3){
  #pragma unroll
  for(int d0=0;d0<2;++d0){s16x4 lo[4],hi[4];
    #pragma unroll
    for(int ks=0;ks<4;++ks){
      asm volatile("ds_read_b64_tr_b16 %0,%1 offset:%c2":"=&v"(lo[ks]):"v"(vb),"i"(d0*4096+ks*1024):"memory");
      asm volatile("ds_read_b64_tr_b16 %0,%1 offset:%c2":"=&v"(hi[ks]):"v"(vb),"i"(d0*4096+ks*1024+512):"memory");}
    asm volatile("s_waitcnt lgkmcnt(0)":::"memory");SBAR();
    #define PK(k) (bf16x8){lo[k][0],lo[k][1],lo[k][2],lo[k][3],hi[k][0],hi[k][1],hi[k][2],hi[k][3]}
    o[d0]=__builtin_amdgcn_mfma_f32_32x32x16_bf16(pa0,PK(0),o[d0],0,0,0);
    o[d0]=__builtin_amdgcn_mfma_f32_32x32x16_bf16(pa1,PK(1),o[d0],0,0,0);
    o[d0]=__builtin_amdgcn_mfma_f32_32x32x16_bf16(pa2,PK(2),o[d0],0,0,0);
    o[d0]=__builtin_amdgcn_mfma_f32_32x32x16_bf16(pa3,PK(3),o[d0],0,0,0);
    #undef PK
  }
}

#ifndef ATTN_STORE16
#define ATTN_STORE16(p,v) (*(u32x4*)(p)=(v))
#endif
template<int THRL,bool NOMAX> __device__ __forceinline__ void attn_unit(int b,int h,int qb,const bf16*Q,const bf16*__restrict__ K,const bf16*__restrict__ V,bf16*O,char*shm,const float*qgain,const float*ropef){
  int tid_l=threadIdx.x; asm volatile("":"+v"(tid_l)); const int tid=tid_l,lane=tid&63,r32=lane&31,hi=lane>>5; const int wid=__builtin_amdgcn_readfirstlane(tid>>6);
  const long rowbase=(long)b*SEQ; const int q0=qb*QB;
  const bf16*Qw=Q+(rowbase+q0+wid*QBLK)*QP+h*D;
  const bf16*Kh=K+rowbase*KP+(h>>2)*D,*Vh=V+rowbase*KP+(h>>2)*D;
  const unsigned lds0=(unsigned)(uintptr_t)shm;
  float*wsf=(float*)(shm+LDS_WS)+wid*64;
  const bf16*ksrc=Kh+(long)lane*KP+wid*8;
  const bf16*vsrc=Vh+(long)(16*(wid&3)+(lane>>2))*KP+(wid>>2)*32+(lane&3)*8;
  const unsigned kdst=lds0+LDS_K+wid*1024, vdst=lds0+LDS_V+wid*1024;
  #define DMA_K(t,slot) glds16(ksrc+(long)(t)*KVBLK*KP,(unsigned)__builtin_amdgcn_readfirstlane(kdst+(slot)))
  #define DMA_V(t,slot) glds16(vsrc+(long)(t)*KVBLK*KP,(unsigned)__builtin_amdgcn_readfirstlane(vdst+(slot)))
  const int vb0=(int)(lds0+LDS_V)+((lane>>4)&1)*32+(lane&3)*8+(4*hi+((lane&15)>>2))*64;
  const char*Kbase=shm+LDS_K; bf16x8 kf[8];
  const lds_cptr shm3=(lds_cptr)shm; const lds_cptr kp0=shm3+LDS_K+hi*1024+r32*16; const lds_cptr vp0=shm3+LDS_V+((lane>>4)&1)*32+(lane&3)*8+(4*hi+((lane&15)>>2))*64;
  const int NT=SEQ/KVBLK;
  DMA_K(0,0);DMA_V(0,0);DMA_K(1,SLOTB);
  bf16x8 qr[4];
  #pragma unroll
  for(int d0=0;d0<4;++d0)qr[d0]=*reinterpret_cast<const bf16x8*>(&Qw[(long)r32*QP+d0*16+hi*8]);
  { float ssq=0.f;
    #pragma unroll
    for(int d0=0;d0<4;++d0){
      #pragma unroll
      for(int i=0;i<8;++i){const float v=__uint_as_float((unsigned)(unsigned short)qr[d0][i]<<16);ssq+=v*v;}}
    ssq+=__shfl_xor(ssq,32);
    const float rs=__builtin_amdgcn_rsqf(ssq*(1.0f/64.0f)+1e-6f)*C2;
    const int spos=q0+wid*QBLK+r32;
    #pragma unroll
    for(int d0=0;d0<4;++d0){
      const float*gp=qgain+16*d0+8*hi; const f32x4q g0=*reinterpret_cast<const f32x4q*>(gp),g1=*reinterpret_cast<const f32x4q*>(gp+4);
      const float*rp=ropef+2*(((d0<2)?((spos>>6)*16):((128+(spos&63))*16))+((8*d0)&15)+4*hi);
      const f32x4q c0=*reinterpret_cast<const f32x4q*>(rp),c1=*reinterpret_cast<const f32x4q*>(rp+4);
      float y[8];
      #pragma unroll
      for(int i=0;i<8;++i)y[i]=__uint_as_float((unsigned)(unsigned short)qr[d0][i]<<16)*rs*(i<4?g0[i]:g1[i-4]);
      u32x4 w;
      w.x=cvtpk_s(y[0]*c0[0]-y[1]*c0[1],y[0]*c0[1]+y[1]*c0[0]); w.y=cvtpk_s(y[2]*c0[2]-y[3]*c0[3],y[2]*c0[3]+y[3]*c0[2]);
      w.z=cvtpk_s(y[4]*c1[0]-y[5]*c1[1],y[4]*c1[1]+y[5]*c1[0]); w.w=cvtpk_s(y[6]*c1[2]-y[7]*c1[3],y[6]*c1[3]+y[7]*c1[2]);
      qr[d0]=__builtin_bit_cast(bf16x8,w);}
  }
  float mhat=0.f,l_reg=0.f;f32x16 o[2];o[0]=f32x16{};o[1]=f32x16{};f32x16 negm=f32x16{};asm volatile("":"+v"(negm));
  const int qrel=wid*QBLK+r32;
  #define CMASK(P0,P1,t) do{}while(0)
  bool resc=false;
  #define START(P0,P1) do{ resc=false; if constexpr(!NOMAX) { const float rm=rowmax(P0,P1); const float dl=rm; mhat=fadd_s(mhat,dl); \
      _Pragma("unroll") for(int r=0;r<16;++r){P0[r]=fsub_s(P0[r],dl);P1[r]=fsub_s(P1[r],dl);} \
      _Pragma("unroll") for(int r=0;r<16;++r)negm[r]=-mhat; asm volatile("":"+v"(negm)); } \
    _Pragma("unroll") for(int r=0;r<16;++r)P0[r]=__builtin_amdgcn_exp2f(P0[r]); }while(0)
  #define RESC() do{ if(resc){ asm volatile("s_waitcnt lgkmcnt(0)":::"memory"); \
      _Pragma("unroll") for(int d_=0;d_<2;++d_) _Pragma("unroll") for(int r=0;r<16;++r)o[d_][r]*=wsf[crow(r,hi)]; } }while(0)
  f32x16 pA0,pA1,pB0,pB1;
  int sl_prev=0,sl_cur=0,sl_next=SLOTB;
  #define ROT() do{sl_prev=sl_cur;sl_cur=sl_next;sl_next=(sl_next==(NSLOT-1)*SLOTB)?0:sl_next+SLOTB;}while(0)
  DMA_K(2,2*SLOTB);
  WAIT_BAR(3);
  qkt(pA0,pA1,Kbase,qr,negm,r32,hi);asm volatile("s_nop 15\n\ts_nop 7":"+v"(pA0),"+v"(pA1));CMASK(pA0,pA1,0);
  START(pA0,pA1);
  _Pragma("unroll") for(int r=0;r<16;++r)pA1[r]=__builtin_amdgcn_exp2f(pA1[r]);
  WAIT_BAR(0);
  DMA_K(3,0);DMA_V(1,SLOTB);
  ROT();
  kload8(kf,kp0+sl_cur);
  WAIT_BAR(2);
  s16x4 vlo[8],vhi[8]; u32x4 pw0,pw1,pw2,pw3;
  #define PKW(P,B) cvtpk_s(P[B],P[B+1])
  #define PAF(k) __builtin_bit_cast(bf16x8,pw##k)
  #define VFR(i) (bf16x8){vlo[i][0],vlo[i][1],vlo[i][2],vlo[i][3],vhi[i][0],vhi[i][1],vhi[i][2],vhi[i][3]}
  #define PIN(x) asm volatile("":"+v"(x))
  #define MX3(a,b,c) __builtin_fmaxf(__builtin_fmaxf((a),(b)),(c))
  #define GAPA(MF,A0,A1,A2,A3,W0,W1,PW) do{ MF; sacc+=A0; sacc+=A1; sacc+=A2; sacc+=A3; PIN(sacc); W0; W1; PIN(PW); SBAR(); }while(0)
  #define EX(v) __builtin_amdgcn_exp2f(v)
  #define GAPB(MF,X,B) do{ MF; X[B]=EX(X[B]); X[B+1]=EX(X[B+1]); X[B+2]=EX(X[B+2]); X[B+3]=EX(X[B+3]); PIN(X); SBAR(); }while(0)
  #define VRD(i) do{ vlo[i]=vtr(vp_+(((i)>>2)*4096+((i)&3)*1024)); vhi[i]=vtr(vp_+(((i)>>2)*4096+((i)&3)*1024+512)); }while(0)
  #define KRD(G,j) do{ if(G){ kload2(kf,kp0+sl_next,j); SBAR(); } }while(0)
  #define STEP(C0,C1,P0,P1,t,GK,GV,GL) do{ SBAR(); \
    const lds_cptr vp_=vp0+sl_prev; \
    VRD(0); SBAR(); float sacc=(P0[0]+P0[1]); \
    GAPA(C0=__builtin_amdgcn_mfma_f32_32x32x16_bf16(kf[0],qr[0],negm,0,0,0), P0[2],P0[3],P0[4],P0[5],     pw0[0]=PKW(P0,0), pw0[1]=PKW(P0,2), pw0); \
    VRD(4); SBAR(); GAPA(C1=__builtin_amdgcn_mfma_f32_32x32x16_bf16(kf[1],qr[0],negm,0,0,0), P0[6],P0[7],P0[8],P0[9],     pw0[2]=PKW(P0,4), pw0[3]=PKW(P0,6), pw0); \
    VRD(1); SBAR(); GAPA(C0=__builtin_amdgcn_mfma_f32_32x32x16_bf16(kf[2],qr[1],C0,0,0,0),   P0[10],P0[11],P0[12],P0[13], pw1[0]=PKW(P0,8), pw1[1]=PKW(P0,10), pw1); \
    VRD(5); SBAR(); GAPA(C1=__builtin_amdgcn_mfma_f32_32x32x16_bf16(kf[3],qr[1],C1,0,0,0),   P0[14],P0[15],P1[0],P1[1],   pw1[2]=PKW(P0,12),pw1[3]=PKW(P0,14), pw1); \
    VRD(2); SBAR(); GAPA(C0=__builtin_amdgcn_mfma_f32_32x32x16_bf16(kf[4],qr[2],C0,0,0,0),   P1[2],P1[3],P1[4],P1[5],     pw2[0]=PKW(P1,0), pw2[1]=PKW(P1,2), pw2); \
    VRD(6); SBAR(); GAPA(C1=__builtin_amdgcn_mfma_f32_32x32x16_bf16(kf[5],qr[2],C1,0,0,0),   P1[6],P1[7],P1[8],P1[9],     pw2[2]=PKW(P1,4), pw2[3]=PKW(P1,6), pw2); \
    VRD(3); SBAR(); GAPA(C0=__builtin_amdgcn_mfma_f32_32x32x16_bf16(kf[6],qr[3],C0,0,0,0),   P1[10],P1[11],P1[12],P1[13], pw3[0]=PKW(P1,8), pw3[1]=PKW(P1,10), pw3); \
    VRD(7); SBAR(); GAPA(C1=__builtin_amdgcn_mfma_f32_32x32x16_bf16(kf[7],qr[3],C1,0,0,0),   P1[14],P1[15],0.f,0.f,       pw3[2]=PKW(P1,12),pw3[3]=PKW(P1,14), pw3); \
    l_reg+=sacc; \
    if(GK){DMA_K((t)+3,sl_cur);} if(GV){DMA_V((t)+1,sl_next);} \
    CMASK(C0,C1,t); \
    if constexpr(!NOMAX) { float a=MX3(C0[0],C0[1],C1[0]),b=MX3(C0[2],C0[3],C1[1]); a=MX3(a,C1[2],C1[3]); \
      _Pragma("unroll") for(int r=4;r<16;r+=4){a=MX3(a,C0[r],C0[r+1]);b=MX3(b,C0[r+2],C0[r+3]);a=MX3(a,C1[r],C1[r+1]);b=MX3(b,C1[r+2],C1[r+3]);} \
      float rm=__builtin_fmaxf(a,b); { auto rr=__builtin_amdgcn_permlane32_swap(__float_as_uint(rm),__float_as_uint(rm),false,false); rm=__builtin_fmaxf(__uint_as_float(rr[0]),__uint_as_float(rr[1])); } \
      resc=false; \
      if(__builtin_expect(__any(rm>(float)THRL),0)){ const float dl=__builtin_fmaxf(rm,0.f); mhat+=dl; \
        _Pragma("unroll") for(int r=0;r<16;++r){C0[r]-=dl;C1[r]-=dl;} \
        _Pragma("unroll") for(int r=0;r<16;++r)negm[r]=-mhat; asm volatile("":"+v"(negm)); \
        const float f=__builtin_amdgcn_exp2f(-dl); l_reg*=f; if(hi==0)wsf[r32]=f; resc=true; } } \
    SBAR(); \
    GAPB(o[0]=__builtin_amdgcn_mfma_f32_32x32x16_bf16(PAF(0),VFR(0),o[0],0,0,0), C0,0); \
    GAPB(o[1]=__builtin_amdgcn_mfma_f32_32x32x16_bf16(PAF(0),VFR(4),o[1],0,0,0), C0,4); \
    KRD(GL,0); GAPB(o[0]=__builtin_amdgcn_mfma_f32_32x32x16_bf16(PAF(1),VFR(1),o[0],0,0,0), C0,8); \
    KRD(GL,1); GAPB(o[1]=__builtin_amdgcn_mfma_f32_32x32x16_bf16(PAF(1),VFR(5),o[1],0,0,0), C0,12); \
    KRD(GL,2); GAPB(o[0]=__builtin_amdgcn_mfma_f32_32x32x16_bf16(PAF(2),VFR(2),o[0],0,0,0), C1,0); \
    KRD(GL,3); GAPB(o[1]=__builtin_amdgcn_mfma_f32_32x32x16_bf16(PAF(2),VFR(6),o[1],0,0,0), C1,4); \
    GAPB(o[0]=__builtin_amdgcn_mfma_f32_32x32x16_bf16(PAF(3),VFR(3),o[0],0,0,0), C1,8); \
    GAPB(o[1]=__builtin_amdgcn_mfma_f32_32x32x16_bf16(PAF(3),VFR(7),o[1],0,0,0), C1,12); \
    }while(0)
  if(__builtin_amdgcn_readfirstlane((int)threadIdx.x)>=256)__builtin_amdgcn_s_setprio(1);
  int t=1;
  #undef CMASK
  #define CMASK(P0,P1,t) do{}while(0)
  for(;t+5<NT;t+=2){
    STEP(pB0,pB1,pA0,pA1,t,true,true,true);     WAIT_BAR(2); RESC(); ROT();
    STEP(pA0,pA1,pB0,pB1,t+1,true,true,true);   WAIT_BAR(2); RESC(); ROT();
  }
  #undef CMASK
  #define CMASK(P0,P1,t) do{}while(0)
  #define ENDW(tt) do{ if((tt)+3<NT){WAIT_BAR(2);} else if((tt)+2<NT){WAIT_BAR(1);} else {WAIT_BAR(0);} }while(0)
  for(;t+1<NT;t+=2){
    STEP(pB0,pB1,pA0,pA1,t,(t+3<NT),(t+1<NT),(t+1<NT));       ENDW(t);   RESC(); ROT();
    STEP(pA0,pA1,pB0,pB1,t+1,(t+4<NT),(t+2<NT),(t+2<NT));     ENDW(t+1); RESC(); ROT();
  }
  STEP(pB0,pB1,pA0,pA1,NT-1,false,false,false); RESC();
  { float sacc=pB0[0]+pB0[1]; _Pragma("unroll") for(int r=2;r<16;++r)sacc+=pB0[r]; _Pragma("unroll") for(int r=0;r<16;++r)sacc+=pB1[r]; l_reg+=sacc;
    pw0=(u32x4){PKW(pB0,0),PKW(pB0,2),PKW(pB0,4),PKW(pB0,6)};pw1=(u32x4){PKW(pB0,8),PKW(pB0,10),PKW(pB0,12),PKW(pB0,14)};pw2=(u32x4){PKW(pB1,0),PKW(pB1,2),PKW(pB1,4),PKW(pB1,6)};pw3=(u32x4){PKW(pB1,8),PKW(pB1,10),PKW(pB1,12),PKW(pB1,14)};
    SBAR(); pv(o,vb0+sl_cur,PAF(0),PAF(1),PAF(2),PAF(3)); }
  #undef PKW
  #undef PAF
  #undef VFR
  #undef PIN
  #undef MX3
  #undef GAPA
  #undef GAPB
  #undef EX
  #undef VRD
  #undef KRD
  #undef STEP
  #undef ENDW
  __builtin_amdgcn_s_setprio(0);
  {auto rr=__builtin_amdgcn_permlane32_swap(__float_as_uint(l_reg),__float_as_uint(l_reg),false,false);l_reg=__uint_as_float(rr[0])+__uint_as_float(rr[1]);}
  if(hi==0)wsf[32+r32]=l_reg;asm volatile("s_waitcnt lgkmcnt(0)":::"memory");
  float rli[16];
  #pragma unroll
  for(int r=0;r<16;++r)rli[r]=__builtin_amdgcn_rcpf(wsf[32+crow(r,hi)]);
  bf16*Ow=O+(rowbase+q0+wid*QBLK)*OP+h*D;
  { bf16*stg=(bf16*)(shm+LDS_OST)+wid*2048;
    #pragma unroll
    for(int r=0;r<16;++r){const int orow=crow(r,hi);
      #pragma unroll
      for(int d0=0;d0<2;++d0)stg[orow*64+d0*32+r32]=__float2bfloat16(o[d0][r]*rli[r]);}
    asm volatile("s_waitcnt lgkmcnt(0)":::"memory");
    #pragma unroll
    for(int i=0;i<4;++i){const int row=i*8+(lane>>3),ch=lane&7; const u32x4 v=*(const u32x4*)(stg+row*64+ch*8); ATTN_STORE16(Ow+(long)row*OP+ch*8,v);} }
  asm volatile("s_waitcnt lgkmcnt(0)\n\ts_barrier":::"memory");
  #undef DMA_K
  #undef DMA_V
  #undef CMASK
  #undef START
  #undef RESC
  #undef ROT
}
constexpr int ATTN_LDS_BYTES=LDS_BYTES;
#undef SBAR
#undef WAIT_BAR
}
#define XB_TMO      128
#define XB_XCNT(j)  (256  + 64 * (j))
#define XB_XSUB(j)  (1280 + 64 * (j))
#define XB_XGEN(j)  (2304 + 64 * (j))
#define XB_TOP      3328
#define XB_TOPGEN   3392
#define XCD_BAR_WORDS 3456
#define XB_SPIN_CAP (1u << 18)

__device__ __forceinline__ unsigned xb_ld(unsigned* p)              { return __hip_atomic_load(p, __ATOMIC_RELAXED, __HIP_MEMORY_SCOPE_AGENT); }
__device__ __forceinline__ unsigned xb_add(unsigned* p, unsigned v) { return __hip_atomic_fetch_add(p, v, __ATOMIC_RELAXED, __HIP_MEMORY_SCOPE_AGENT); }
__device__ __forceinline__ unsigned xb_xcc_id() { return (unsigned)__builtin_amdgcn_s_getreg((3 << 11) | 20) & 0xFu; }
#define XB_SPIN(cond, bar) do { unsigned _sp = 0; while (cond) { __builtin_amdgcn_s_sleep(1); \
    if ((++_sp & 255u) == 0u) { if (xb_ld(&(bar)[XB_TMO])) break; if (_sp > XB_SPIN_CAP) { atomicAdd(&(bar)[XB_TMO], 1u); break; } } } } while (0)

struct XcdBarrier {
    unsigned* bar; unsigned x;
    volatile LAS unsigned* st;
};

__device__ __forceinline__ XcdBarrier xcd_barrier_post(unsigned* bar, volatile LAS unsigned* st) {
    XcdBarrier b; b.bar = bar; b.x = xb_xcc_id(); b.st = st;
    if (threadIdx.x == 0) (void)xb_add(&bar[XB_XCNT(b.x)], 1u);
    return b;
}
__device__ __forceinline__ void xcd_barrier_complete(unsigned* bar, unsigned x, unsigned& nloc, unsigned& nx) {
    const unsigned G = gridDim.x * gridDim.y * gridDim.z;
    unsigned sum, cnt, mine, sp = 0u;
    for (;;) {
        sum = 0u; cnt = 0u; mine = 0u;
#pragma unroll
        for (unsigned j = 0; j < 16; ++j) { const unsigned c = xb_ld(&bar[XB_XCNT(j)]); sum += c; cnt += (c > 0u) ? 1u : 0u; mine = (j == x) ? c : mine; }
        if (sum == G) break;
        __builtin_amdgcn_s_sleep(1);
        if ((++sp & 255u) == 0u) { if (xb_ld(&bar[XB_TMO])) break; if (sp > XB_SPIN_CAP) { atomicAdd(&bar[XB_TMO], 1u); break; } }
    }
    nloc = mine > 0u ? mine : 1u; nx = cnt > 0u ? cnt : 1u;
}

__device__ __forceinline__ void xcd_barrier(const XcdBarrier& b) {
    asm volatile("s_waitcnt vmcnt(0)" ::: "memory");
    __syncthreads();
    if (threadIdx.x == 0) {
        unsigned* bar = b.bar;
        __builtin_amdgcn_s_waitcnt(0);
        unsigned nloc = b.st[0], nx = b.st[1];
        if (nloc == 0u) { xcd_barrier_complete(bar, b.x, nloc, nx); b.st[0] = nloc; b.st[1] = nx; }
        const unsigned old = xb_add(&bar[XB_XSUB(b.x)], 1u);
        const unsigned gen = old / nloc;
        if (old + 1u == (gen + 1u) * nloc) {
            __builtin_amdgcn_fence(__ATOMIC_RELEASE, "agent");
            asm volatile("s_waitcnt vmcnt(0)" ::: "memory");
            const unsigned og = xb_add(&bar[XB_TOP], 1u);
            const unsigned tg = og / nx;
            if (og + 1u == (tg + 1u) * nx) xb_add(&bar[XB_TOPGEN], 1u);
            else XB_SPIN(xb_ld(&bar[XB_TOPGEN]) == tg, bar);
            __builtin_amdgcn_fence(__ATOMIC_ACQUIRE, "agent");
            xb_add(&bar[XB_XGEN(b.x)], 1u);
            asm volatile("s_waitcnt vmcnt(0)" ::: "memory");
        } else {
            XB_SPIN(xb_ld(&bar[XB_XGEN(b.x)]) == gen, bar);
            __builtin_amdgcn_fence(__ATOMIC_ACQUIRE, "agent");
            asm volatile("s_waitcnt vmcnt(0)" ::: "memory");
        }
    }
    __syncthreads();
}

namespace mk {
using pg8::bf16_t; using pg8::bf16x8; using pg8::f32x4; using pg8::u32x4;
typedef short s16x4 __attribute__((ext_vector_type(4)));
typedef float f32x16 __attribute__((ext_vector_type(16)));
typedef float f32x2 __attribute__((ext_vector_type(2)));
typedef unsigned u32x2 __attribute__((ext_vector_type(2)));

constexpr int NWAVES = 8, NTHR = 512;
constexpr int SEQ = 8192, NBATCH = 2, T = NBATCH * SEQ, DM = 1024, FF = 2816, NIN = 2320, NINP = 2560, NMEM = 256;
constexpr float EPS = 1e-6f, LOG2E = 1.4426950408889634f;
constexpr int OFF_Q = 0, OFF_K = 512, OFF_V = 640, OFF_CONV = 768, OFF_MQ = 1280, OFF_MK = 1536, OFF_MV = 1792, OFF_MO = 2048, OFF_MG = 2304;
constexpr int LDS_BYTES = 147456;
#ifndef PHM
#define PHM 1023
#endif
#ifndef GM
#define GM 0xffff
#endif

constexpr size_t MiB = 1u << 20, KiB = 1024;
constexpr size_t WS_W = 0, W_LAYER = 48 * MiB;
constexpr size_t O_W13A = 0, O_W2A = O_W13A + (size_t)5632 * 1024 * 2, O_WIN = O_W2A + (size_t)1024 * 2816 * 2, O_WOUT = O_WIN + (size_t)2560 * 1024 * 2, O_WQ = O_WOUT + 2 * MiB,
                 O_WKV = O_WQ + 2 * MiB, O_WO = O_WKV + 4 * MiB, O_W13B = O_WO + 2 * MiB, O_W2B = O_W13B + (size_t)5632 * 1024 * 2;
static_assert(O_W2B + (size_t)1024 * 2816 * 2 == W_LAYER, "weight map");
constexpr size_t WS_XN = 96 * MiB, WS_H = 128 * MiB, WS_Y = 216 * MiB, WS_GATES = 248 * MiB, WS_ROPE = 249 * MiB, WS_SS = 250 * MiB, WS_KX = 251 * MiB, WS_VXT = 253 * MiB, WS_END = 255 * MiB;
constexpr size_t ML_DC = WS_XN, ML_CST = WS_XN + 17 * MiB, ML_NST = WS_XN + 25 * MiB, ML_MST = WS_XN + 26 * MiB, ML_BEND = ML_MST + 64 * KiB, ML_MLOC = ML_MST + 128 * KiB;
constexpr size_t WS_CTL = 255 * MiB, CTL_BYTES = 16384, WS_TOTAL = WS_CTL + CTL_BYTES;
constexpr int MISC_OFF = LDS_BYTES - 64;
constexpr size_t WS_MEMN = WS_Y + 8 * MiB, WS_KVRAW = WS_H + 80 * MiB, WS_QX = WS_Y, WS_OX = WS_H;

__device__ const float INVF[16] = {1.0f, 0.5623413324356079f, 0.3162277638912201f, 0.17782793939113617f, 0.10000000149011612f, 0.05623413249850273f, 0.03162277489900589f, 0.017782794311642647f,
    0.009999999776482582f, 0.005623413249850273f, 0.003162277629598975f, 0.0017782794311642647f, 0.0010000000474974513f, 0.000562341301701963f, 0.0003162277571391314f, 0.00017782794020604342f};

struct Params { const float* in[26]; float* out; unsigned char* ws; };
typedef const __attribute__((address_space(4))) Params* KP;
enum { I_X = 0, I_MEM, I_F1N, I_F1W13, I_F1W2, I_MIXN, I_WIN, I_AQN, I_AKN, I_CW, I_CB, I_CLG, I_CLB, I_MGB, I_MON, I_WOUT, I_XN, I_MN, I_XWQ, I_XWKV, I_XQN, I_XKN, I_XWO, I_F2N, I_F2W13, I_F2W2 };

#define LDS_WAIT() asm volatile("s_waitcnt lgkmcnt(0)" ::: "memory")
__device__ __forceinline__ float bf2f(unsigned short h) { return __uint_as_float((unsigned)h << 16); }
__device__ __forceinline__ unsigned pk2(float lo, float hi) { return pg8::cvt_pk_bf16(lo, hi); }
__device__ __forceinline__ float wave_sum(float v) {
#pragma unroll
    for (int o = 1; o < 64; o <<= 1) v += __shfl_xor(v, o);
    return v;
}
__device__ __forceinline__ float wave_max(float v) {
#pragma unroll
    for (int o = 1; o < 64; o <<= 1) v = fmaxf(v, __shfl_xor(v, o));
    return v;
}
__device__ __forceinline__ float wave_scan_add(float v, int lane) {
#pragma unroll
    for (int o = 1; o < 64; o <<= 1) { const float t = __shfl_up(v, o); if (lane >= o) v += t; }
    return v;
}
__device__ __forceinline__ float wave_scan_max(float v, int lane) {
#pragma unroll
    for (int o = 1; o < 64; o <<= 1) { const float t = __shfl_up(v, o); if (lane >= o) v = fmaxf(v, t); }
    return v;
}
__device__ __forceinline__ float logsigmoid_f(float x) { return fminf(x, 0.f) - log1pf(expf(-fabsf(x))); }
__device__ __forceinline__ float sigmoid_f(float x) { return 1.0f / (1.0f + __expf(-x)); }
__device__ __forceinline__ int crow(int r, int hi) { return (r & 3) + 8 * (r >> 2) + 4 * hi; }
__device__ __forceinline__ void unpack8(const bf16x8 v, float* f) {
#pragma unroll
    for (int i = 0; i < 8; ++i) f[i] = bf2f((unsigned short)v[i]);
}

__device__ __forceinline__ void transpose_item(const float* W, const float* gain, int K, int N, bf16_t* WT, int dst_row0, int k0, int n0, float* scr, int lane) {
    const int nn = n0 + (lane & 31);
    float wv[32];
    const float* wp = W + (size_t)(k0 + (lane >> 5)) * N + nn; const bool okn = nn < N;
#pragma unroll
    for (int i = 0; i < 32; ++i) wv[i] = okn ? wp[(size_t)(2 * i) * N] : 0.f;
    if (gain) {
#pragma unroll
        for (int i = 0; i < 32; ++i) wv[i] *= gain[k0 + 2 * i + (lane >> 5)]; }
#pragma unroll
    for (int i = 0; i < 32; ++i) scr[(2 * i + (lane >> 5)) * 33 + (lane & 31)] = wv[i];
    LDS_WAIT(); asm volatile("" ::: "memory");
    const int c = lane & 7;
#pragma unroll
    for (int j = 0; j < 4; ++j) { const int n = (lane >> 3) + 8 * j; const float* s = scr + (8 * c) * 33 + n;
        u32x4 o; o.x = pk2(s[0 * 33], s[1 * 33]); o.y = pk2(s[2 * 33], s[3 * 33]); o.z = pk2(s[4 * 33], s[5 * 33]); o.w = pk2(s[6 * 33], s[7 * 33]);
        *(u32x4*)(WT + (size_t)(dst_row0 + n) * K + k0 + 8 * c) = o; }
    LDS_WAIT(); asm volatile("" ::: "memory");
}
__device__ __forceinline__ void conv_weight(const float* W, const float* gain, int K, int N, int NP, bf16_t* WT, bool swz, int& cum, float* scr, int gw, int ngw, int lane) {
    const int nblk = NP / 32, nitems = (K / 64) * nblk;
    const int first = ((gw - (cum % ngw)) + ngw) % ngw;
    for (int it = first; it < nitems; it += ngw) {
        const int kb = it / nblk, nb = it % nblk, n0 = 32 * nb;
        int drow = n0;
        if (swz) drow = (n0 < FF) ? (n0 / 128) * 256 + (n0 % 128) : ((n0 - FF) / 128) * 256 + 128 + ((n0 - FF) % 128);
        transpose_item(W, gain, K, N, WT, drow, 64 * kb, n0, scr, lane);
    }
    cum += nitems;
}
__device__ __forceinline__ void norm_rows(const float* x, const float* gain, bf16_t* xn, int nrows, int vcu, int G) {
    int tid_l = threadIdx.x; asm volatile("" : "+v"(tid_l)); const int tid = tid_l, lane = tid & 63, wave = __builtin_amdgcn_readfirstlane(tid >> 6); (void)tid; (void)lane; (void)wave;
    const int gw = vcu * NWAVES + wave, ngw = G * NWAVES;
    f32x4 g[4];
#pragma unroll
    for (int j = 0; j < 4; ++j) g[j] = ((const f32x4*)gain)[lane + 64 * j];
    for (int m = gw; m < nrows; m += ngw) {
        const f32x4* xr = (const f32x4*)(x + (size_t)m * DM) + lane; f32x4 v[4]; float s = 0.f;
#pragma unroll
        for (int j = 0; j < 4; ++j) { v[j] = xr[64 * j]; s += (v[j].x * v[j].x + v[j].y * v[j].y) + (v[j].z * v[j].z + v[j].w * v[j].w); }
        const float rstd = rsqrtf(wave_sum(s) * (1.f / DM) + EPS);
        u32x2* o = (u32x2*)(xn + (size_t)m * DM) + lane;
#pragma unroll
        for (int j = 0; j < 4; ++j) { const f32x4 y = v[j] * rstd * g[j]; u32x2 w; w.x = pk2(y.x, y.y); w.y = pk2(y.z, y.w); o[64 * j] = w; }
    }
}
constexpr int W_ITEMS_LAYER = 12288;
__device__ __forceinline__ void convert_item(KP P, int gi, float* scr, int lane) {
    const int l = gi / W_ITEMS_LAYER, r = gi % W_ITEMS_LAYER; unsigned char* wb = P->ws + WS_W + (size_t)l * W_LAYER;
    int K = DM, N = DM, NP = DM, it = r; bool swz = false; const float* W; const float* gain = nullptr; bf16_t* WT;
    if (r < 2816)       { W = P->in[I_F1W13] + (size_t)l * DM * 2 * FF; gain = P->in[I_F1N] + l * DM; N = 2 * FF; NP = 2 * FF; WT = (bf16_t*)(wb + O_W13A); swz = true; it = r; }
    else if (r < 4224)  { W = P->in[I_F1W2] + (size_t)l * FF * DM; K = FF; WT = (bf16_t*)(wb + O_W2A); it = r - 2816; }
    else if (r < 5504)  { W = P->in[I_WIN] + (size_t)l * DM * NIN; gain = P->in[I_MIXN] + l * DM; N = NIN; NP = NINP; WT = (bf16_t*)(wb + O_WIN); it = r - 4224; }
    else if (r < 6016)  { W = P->in[I_WOUT] + (size_t)l * DM * DM; WT = (bf16_t*)(wb + O_WOUT); it = r - 5504; }
    else if (r < 6528)  { W = P->in[I_XWQ] + (size_t)l * DM * DM; gain = P->in[I_XN] + l * DM; WT = (bf16_t*)(wb + O_WQ); it = r - 6016; }
    else if (r < 7552)  { W = P->in[I_XWKV] + (size_t)l * DM * 2 * DM; N = 2 * DM; NP = 2 * DM; WT = (bf16_t*)(wb + O_WKV); it = r - 6528; }
    else if (r < 8064)  { W = P->in[I_XWO] + (size_t)l * DM * DM; WT = (bf16_t*)(wb + O_WO); it = r - 7552; }
    else if (r < 10880) { W = P->in[I_F2W13] + (size_t)l * DM * 2 * FF; gain = P->in[I_F2N] + l * DM; N = 2 * FF; NP = 2 * FF; WT = (bf16_t*)(wb + O_W13B); swz = true; it = r - 8064; }
    else                { W = P->in[I_F2W2] + (size_t)l * FF * DM; K = FF; WT = (bf16_t*)(wb + O_W2B); it = r - 10880; }
    const int nblk = NP / 32, kb = it / nblk, nb = it % nblk, n0 = 32 * nb;
    int drow = n0;
    if (swz) drow = (n0 < FF) ? (n0 / 128) * 256 + (n0 % 128) : ((n0 - FF) / 128) * 256 + 128 + ((n0 - FF) % 128);
    transpose_item(W, gain, K, N, WT, drow, 64 * kb, n0, scr, lane);
}
__device__ __forceinline__ void convert_items(KP P, unsigned char* lds, int first, int count, int widx, int nw) {
    asm volatile("" : "+s"(P)); int tid_l = threadIdx.x; asm volatile("" : "+v"(tid_l)); const int tid = tid_l, lane = tid & 63, wave = __builtin_amdgcn_readfirstlane(tid >> 6);
    float* scr = (float*)(lds + wave * 16384);
    for (int it = widx * 8 + wave; it < count; it += nw * 8) convert_item(P, first + it, scr, lane);
    __syncthreads();
}
__device__ __forceinline__ void xb_rows(const float* x, bf16_t* xb, float* SS, int nrows, int vcu, int G) {
    int tid_l = threadIdx.x; asm volatile("" : "+v"(tid_l)); const int tid = tid_l, lane = tid & 63, wave = __builtin_amdgcn_readfirstlane(tid >> 6);
    const int gw = vcu * NWAVES + wave, ngw = G * NWAVES;
    for (int m0 = gw * 2; m0 < nrows; m0 += ngw * 2) {
        f32x4 v[2][4];
#pragma unroll
        for (int q = 0; q < 2; ++q)
#pragma unroll
            for (int j = 0; j < 4; ++j) v[q][j] = ((const f32x4*)(x + (size_t)(m0 + q) * DM) + lane)[64 * j];
#pragma unroll
        for (int q = 0; q < 2; ++q) { const int m = m0 + q; float s = 0.f;
#pragma unroll
            for (int j = 0; j < 4; ++j) s += (v[q][j].x * v[q][j].x + v[q][j].y * v[q][j].y) + (v[q][j].z * v[q][j].z + v[q][j].w * v[q][j].w);
            s = wave_sum(s);
            u32x2* o = (u32x2*)(xb + (size_t)m * DM) + lane;
#pragma unroll
            for (int j = 0; j < 4; ++j) { u32x2 w; w.x = pk2(v[q][j].x, v[q][j].y); w.y = pk2(v[q][j].z, v[q][j].w); o[64 * j] = w; }
            if (lane < 16) SS[(size_t)m * 16 + lane] = lane == 0 ? s : 0.f; }
    }
}
__device__ __forceinline__ void rope_table(f32x2* tab, int gtid, int gthreads) {
    for (int e = gtid; e < 192 * 16; e += gthreads) {
        const int i = e >> 4, j = e & 15; const int idx = (i < 128) ? i : i - 128;
        const float ang = (float)idx * INVF[j];
        const double ad = (double)ang; const double nq = __builtin_rint(ad * 0.63661977236758134308); const float r = (float)(ad - nq * 1.57079632679489661923);
        const int q = ((int)nq) & 3; const float r2 = r * r;
        const float sn = r + r * r2 * (-1.0f / 6 + r2 * (1.0f / 120 + r2 * (-1.0f / 5040 + r2 * (1.0f / 362880))));
        const float cs = 1.0f + r2 * (-0.5f + r2 * (1.0f / 24 + r2 * (-1.0f / 720 + r2 * (1.0f / 40320 + r2 * (-1.0f / 3628800)))));
        float c, s_; if (q == 0) { s_ = sn; c = cs; } else if (q == 1) { s_ = cs; c = -sn; } else if (q == 2) { s_ = -sn; c = -cs; } else { s_ = -cs; c = sn; }
        tab[e] = (f32x2){c, s_};
    }
}
__device__ __forceinline__ void memprep(KP P, int vcu, int G) {
    asm volatile("" : "+s"(P)); int tid_l = threadIdx.x; asm volatile("" : "+v"(tid_l)); const int tid = tid_l, lane = tid & 63, wave = __builtin_amdgcn_readfirstlane(tid >> 6); (void)tid; (void)lane; (void)wave;
    const int gw = vcu * NWAVES + wave, ngw = G * NWAVES;
    const float* kvraw = (const float*)(P->ws + WS_KVRAW); bf16_t* KX = (bf16_t*)(P->ws + WS_KX); bf16_t* VXT = (bf16_t*)(P->ws + WS_VXT);
    for (int it = gw; it < 4096; it += ngw) {
        const int l = it >> 11, r = it & 2047, bm = r >> 2, h = r & 3, b = bm >> 8, m = bm & 255;
        const float* kv = kvraw + ((size_t)l * 512 + bm) * 2048;
        const f32x4 k = *(const f32x4*)(kv + h * 256 + lane * 4);
        const float rstd = rsqrtf(wave_sum((k.x * k.x + k.y * k.y) + (k.z * k.z + k.w * k.w)) * (1.f / 256) + EPS);
        const f32x4 kg = *(const f32x4*)(P->in[I_XKN] + l * 256 + lane * 4), qg = *(const f32x4*)(P->in[I_XQN] + l * 256 + lane * 4);
        const f32x4 y = k * rstd * kg * qg * (0.0625f * LOG2E);
        const size_t hb = ((size_t)(l * 2 + b) * 4 + h) * 65536;
        u32x2 w; w.x = pk2(y.x, y.y); w.y = pk2(y.z, y.w); *(u32x2*)(KX + hb + (size_t)m * 256 + lane * 4) = w;
        const f32x4 v = *(const f32x4*)(kv + 1024 + h * 256 + lane * 4);
#pragma unroll
        for (int i = 0; i < 4; ++i) VXT[hb + (size_t)(lane * 4 + i) * 256 + m] = (bf16_t)(pk2(v[i], 0.f) & 0xffffu);
    }
}
__device__ __forceinline__ void qkprep(KP P, int l, int vcu, int G) {
    asm volatile("" : "+s"(P)); int tid_l = threadIdx.x; asm volatile("" : "+v"(tid_l)); const int tid = tid_l, lane = tid & 63, wave = __builtin_amdgcn_readfirstlane(tid >> 6); (void)tid; (void)lane; (void)wave;
    const int gw = vcu * NWAVES + wave, ngw = G * NWAVES;
    bf16_t* HM = (bf16_t*)(P->ws + WS_H); const f32x2* rope = (const f32x2*)(P->ws + WS_ROPE);
    const float* qn = P->in[I_AQN] + l * 64; const float* kn = P->in[I_AKN] + l * 64;
    const int j = lane & 31;
    const float qg0 = qn[2 * j], qg1 = qn[2 * j + 1], kg0 = kn[2 * j], kg1 = kn[2 * j + 1];
    for (int tok0 = gw * 4; tok0 < T; tok0 += ngw * 4) {
        unsigned wv[4][5]; f32x2 cs[4];
#pragma unroll
        for (int q = 0; q < 4; ++q) { const int tok = tok0 + q, s = tok & (SEQ - 1); const bf16_t* row = HM + (size_t)tok * NINP;
            cs[q] = rope[(j < 16) ? ((s >> 6) * 16 + j) : ((128 + (s & 63)) * 16 + (j - 16))];
#pragma unroll
            for (int hp = 4; hp < 5; ++hp) wv[q][hp] = *(const unsigned*)(row + (hp * 2 + (lane >> 5)) * 64 + 2 * j); }
#pragma unroll
        for (int q = 0; q < 4; ++q) { bf16_t* row = HM + (size_t)(tok0 + q) * NINP;
#pragma unroll
            for (int hp = 4; hp < 5; ++hp) {
                const int head = hp * 2 + (lane >> 5); unsigned* p = (unsigned*)(row + head * 64 + 2 * j);
                const unsigned w = wv[q][hp]; const float x0 = __uint_as_float(w << 16), x1 = __uint_as_float(w & 0xffff0000u);
                float ss = x0 * x0 + x1 * x1;
#pragma unroll
                for (int o = 1; o < 32; o <<= 1) ss += __shfl_xor(ss, o);
                const float rstd = rsqrtf(ss * (1.f / 64) + EPS);
                const bool isq = head < 8;
                const float y0 = x0 * rstd * (isq ? qg0 : kg0), y1 = x1 * rstd * (isq ? qg1 : kg1);
                const float sc = isq ? attn_body::C2 : 1.0f;
                *p = pk2((y0 * cs[q].x - y1 * cs[q].y) * sc, (y0 * cs[q].y + y1 * cs[q].x) * sc);
            } }
    }
}
__device__ __forceinline__ void conv_phase(KP P, int l, unsigned char* lds, int vcu, int G) {
    asm volatile("" : "+s"(P)); int tid_l = threadIdx.x; asm volatile("" : "+v"(tid_l)); const int tid = tid_l, lane = tid & 63, wave = __builtin_amdgcn_readfirstlane(tid >> 6); (void)tid; (void)lane; (void)wave;
    const bf16_t* HM = (const bf16_t*)(P->ws + WS_H); bf16_t* Y = (bf16_t*)(P->ws + WS_Y);
    float* U = (float*)lds; float* CO = (float*)(lds + 63488);
    const float* dw = P->in[I_CW] + l * 31 * 256; const int ch = tid & 255, half = tid >> 8;
    for (int it = vcu; it < T / 32; it += G) {
        const int tok0 = it * 32, s0 = tok0 & (SEQ - 1), tb = tok0 - s0;
        {   const int rg = tid >> 5, c8 = tid & 31;
#pragma unroll
            for (int p = 0; p < 4; ++p) { const int r = p * 16 + rg; if (r < 62) { const int s = s0 - 15 + r; float uo[8];
                if (s >= 0 && s < SEQ) { const bf16_t* src = HM + (size_t)(tb + s) * NINP + OFF_CONV + c8 * 8; float a[8], g[8]; unpack8(*(const bf16x8*)src, a); unpack8(*(const bf16x8*)(src + 256), g);
#pragma unroll
                    for (int i = 0; i < 8; ++i) uo[i] = a[i] * sigmoid_f(g[i]); }
                else {
#pragma unroll
                    for (int i = 0; i < 8; ++i) uo[i] = 0.f; }
                *(f32x4*)(U + r * 256 + c8 * 8) = (f32x4){uo[0], uo[1], uo[2], uo[3]}; *(f32x4*)(U + r * 256 + c8 * 8 + 4) = (f32x4){uo[4], uo[5], uo[6], uo[7]}; } }
        }
        __syncthreads();
        {   float acc[16]; const float bias = P->in[I_CB][l * 256 + ch];
#pragma unroll
            for (int t = 0; t < 16; ++t) acc[t] = bias;
            const float* ub = U + (half * 16) * 256 + ch; float uw[46], wk[31];
#pragma unroll
            for (int k = 0; k < 31; ++k) wk[k] = dw[k * 256 + ch];
#pragma unroll
            for (int r = 0; r < 46; ++r) uw[r] = ub[r * 256];
#pragma unroll
            for (int k = 0; k < 31; ++k)
#pragma unroll
                for (int t = 0; t < 16; ++t) acc[t] += wk[k] * uw[t + k];
#pragma unroll
            for (int t = 0; t < 16; ++t) CO[(half * 16 + t) * 256 + ch] = acc[t];
        }
        __syncthreads();
        {   const f32x4 lg = *(const f32x4*)(P->in[I_CLG] + l * 256 + lane * 4), lb = *(const f32x4*)(P->in[I_CLB] + l * 256 + lane * 4);
#pragma unroll
            for (int q = 0; q < 4; ++q) { const int t = wave * 4 + q; const f32x4 x = *(const f32x4*)(CO + t * 256 + lane * 4);
                const float mean = wave_sum((x.x + x.y) + (x.z + x.w)) * (1.f / 256); const f32x4 d = x - mean;
                const float var = wave_sum((d.x * d.x + d.y * d.y) + (d.z * d.z + d.w * d.w)) * (1.f / 256); const f32x4 un = d * rsqrtf(var + EPS) * lg + lb;
                u32x2 w; w.x = pk2(un.x * sigmoid_f(un.x), un.y * sigmoid_f(un.y)); w.y = pk2(un.z * sigmoid_f(un.z), un.w * sigmoid_f(un.w));
                *(u32x2*)(Y + (size_t)(tok0 + t) * DM + 512 + lane * 4) = w; }
        }
        __syncthreads();
    }
}
struct GateRaw { float ia, ib, fa, fb; };
__device__ __forceinline__ GateRaw chunk_gates_load(KP P, int tok0, int dir, int h, int lane) {
    const float* G = (const float*)(P->ws + WS_GATES);
    const int ra = dir ? 127 - lane : lane, rb = dir ? 63 - lane : lane + 64;
    const float* ga = G + (size_t)(tok0 + ra) * 16 + dir * 8; const float* gbp = G + (size_t)(tok0 + rb) * 16 + dir * 8;
    GateRaw g; g.ia = ga[h]; g.ib = gbp[h]; g.fa = ga[4 + h]; g.fb = gbp[4 + h]; return g;
}
__device__ __forceinline__ void chunk_gates_calc(KP P, int l, const GateRaw& g, int dir, int h, int lane, float& gia, float& gib, float& ba, float& bb) {
    const float* gb = P->in[I_MGB] + l * 16 + dir * 8;
    gia = g.ia + gb[h]; gib = g.ib + gb[h];
    const float lfa = logsigmoid_f(g.fa + gb[4 + h]), lfb = logsigmoid_f(g.fb + gb[4 + h]);
    ba = wave_scan_add(lfa, lane); const float tot = __shfl(ba, 63); bb = wave_scan_add(lfb, lane) + tot;
}
__device__ __forceinline__ void chunk_gates(KP P, int l, int tok0, int dir, int h, int lane, float& gia, float& gib, float& ba, float& bb) {
    const GateRaw g = chunk_gates_load(P, tok0, dir, h, lane); chunk_gates_calc(P, l, g, dir, h, lane, gia, gib, ba, bb);
}
__device__ __forceinline__ void mlstm_local(KP P, int l, unsigned char* lds, int vcu, int G) {
    asm volatile("" : "+s"(P)); int tid_l = threadIdx.x; asm volatile("" : "+v"(tid_l)); const int tid = tid_l, lane = tid & 63, wave = __builtin_amdgcn_readfirstlane(tid >> 6); (void)tid; (void)lane; (void)wave;
    const bf16_t* HM = (const bf16_t*)(P->ws + WS_H); float* DC = (float*)(P->ws + ML_DC); float* BEND = (float*)(P->ws + ML_BEND); float* MLOC = (float*)(P->ws + ML_MLOC);
    float* Ks = (float*)lds; float* VW0 = (float*)(lds + 32768); float* VW1 = (float*)(lds + 65536); float* wrow = (float*)(lds + 98304);
    const int r = tid >> 2, q4 = tid & 3;
    for (int it0 = vcu; it0 < 512; it0 += 2 * G) {
        bf16x8 Lk0[2], Lk1[2], Lv0[2], Lv1[2], Lka[2], Lkb[2]; GateRaw Lg[2];
#pragma unroll
        for (int q = 0; q < 2; ++q) { const int it = it0 + q * G; const bf16x8 z8 = {0, 0, 0, 0, 0, 0, 0, 0};
            Lk0[q] = z8; Lk1[q] = z8; Lv0[q] = z8; Lv1[q] = z8; Lka[q] = z8; Lkb[q] = z8; Lg[q] = (GateRaw){0.f, 0.f, 0.f, 0.f};
            if (it < 512) { const int b = it >> 8, h = (it >> 6) & 3, c = it & 63, tok0 = b * SEQ + c * 128;
                const bf16_t* src = HM + (size_t)(tok0 + r) * NINP + h * 64 + q4 * 16;
                Lk0[q] = *(const bf16x8*)(src + OFF_MK); Lk1[q] = *(const bf16x8*)(src + OFF_MK + 8); Lv0[q] = *(const bf16x8*)(src + OFF_MV); Lv1[q] = *(const bf16x8*)(src + OFF_MV + 8);
                if (h < 2) { const bf16_t* kp0 = HM + (size_t)(tok0 + r) * NINP + OFF_K + (h & 1) * 64 + q4 * 16; Lka[q] = *(const bf16x8*)kp0; Lkb[q] = *(const bf16x8*)(kp0 + 8); }
                if (wave < 2) Lg[q] = chunk_gates_load(P, tok0, wave, h, lane); } }
#pragma unroll
        for (int q = 0; q < 2; ++q) { const int it = it0 + q * G; if (it < 512) {
        const int b = it >> 8, h = (it >> 6) & 3, c = it & 63, tok0 = b * SEQ + c * 128;
        const int idx0 = ((b * 2 + 0) * 4 + h) * 64 + c, idx1 = ((b * 2 + 1) * 4 + h) * 64 + (63 - c);
        const bf16x8 k0v = Lk0[q], k1v = Lk1[q], v0v = Lv0[q], v1v = Lv1[q];
        bf16_t* kp = (bf16_t*)HM + (size_t)(tok0 + r) * NINP + OFF_K + (h & 1) * 64 + q4 * 16;
        const bf16x8 ka = Lka[q], kb = Lkb[q];
        if (h < 2) {
            float kf[16]; unpack8(ka, kf); unpack8(kb, kf + 8); float ssk = 0.f;
#pragma unroll
            for (int i = 0; i < 16; ++i) ssk += kf[i] * kf[i];
            ssk += __shfl_xor(ssk, 1); ssk += __shfl_xor(ssk, 2);
            const float rsk = rsqrtf(ssk * (1.f / 64) + EPS);
            const int spos = c * 128 + r; const float* kn = P->in[I_AKN] + l * 64 + q4 * 16;
            const float* rp = (const float*)(P->ws + WS_ROPE) + 2 * (((q4 < 2) ? ((spos >> 6) * 16) : ((128 + (spos & 63)) * 16)) + ((8 * q4) & 15));
            unsigned wq[8];
#pragma unroll
            for (int p2 = 0; p2 < 8; ++p2) { const float y0 = kf[2 * p2] * rsk * kn[2 * p2], y1 = kf[2 * p2 + 1] * rsk * kn[2 * p2 + 1]; const float cc = rp[2 * p2], sn = rp[2 * p2 + 1];
                wq[p2] = pk2(y0 * cc - y1 * sn, y0 * sn + y1 * cc); }
            *(u32x4*)kp = (u32x4){wq[0], wq[1], wq[2], wq[3]}; *(u32x4*)(kp + 8) = (u32x4){wq[4], wq[5], wq[6], wq[7]};
        }
        if (wave < 2) {
            const int dir = wave; float gia, gib, ba, bb; chunk_gates_calc(P, l, Lg[q], dir, h, lane, gia, gib, ba, bb);
            const float bend = __shfl(bb, 63); const float lwa = bend - ba + gia, lwb = bend - bb + gib; const float mloc = wave_max(fmaxf(lwa, lwb));
            wrow[dir * 128 + (dir ? 127 - lane : lane)] = expf(lwa - mloc) * 0.125f; wrow[dir * 128 + (dir ? 63 - lane : lane + 64)] = expf(lwb - mloc) * 0.125f;
            if (lane == 0) { BEND[dir ? idx1 : idx0] = bend; MLOC[dir ? idx1 : idx0] = mloc; }
        }
        __syncthreads();
        {   const float w0 = wrow[r], w1 = wrow[128 + r];
#pragma unroll
            for (int hh = 0; hh < 2; ++hh) { float k[8], v[8]; unpack8(hh ? k1v : k0v, k); unpack8(hh ? v1v : v0v, v);
                const int o = r * 64 + q4 * 16 + hh * 8;
                *(f32x4*)(Ks + o) = (f32x4){k[0], k[1], k[2], k[3]}; *(f32x4*)(Ks + o + 4) = (f32x4){k[4], k[5], k[6], k[7]};
                *(f32x4*)(VW0 + o) = (f32x4){v[0] * w0, v[1] * w0, v[2] * w0, v[3] * w0}; *(f32x4*)(VW0 + o + 4) = (f32x4){v[4] * w0, v[5] * w0, v[6] * w0, v[7] * w0};
                *(f32x4*)(VW1 + o) = (f32x4){v[0] * w1, v[1] * w1, v[2] * w1, v[3] * w1}; *(f32x4*)(VW1 + o + 4) = (f32x4){v[4] * w1, v[5] * w1, v[6] * w1, v[7] * w1}; }
        }
        __syncthreads();
        {   const int e0 = (tid >> 4) * 2, d0 = (tid & 15) * 4; const f32x4 z = {0.f, 0.f, 0.f, 0.f}; f32x4 a0 = z, a1 = z, b0 = z, b1 = z, an = z;
            float* dst0 = DC + (size_t)idx0 * 4160; float* dst1 = DC + (size_t)idx1 * 4160;
            if (wave < 2) {
                const float* wn = wrow + wave * 128;
#pragma unroll 4
                for (int rr = 0; rr < 128; ++rr) { const f32x2 v0 = *(const f32x2*)(VW0 + rr * 64 + e0), v1 = *(const f32x2*)(VW1 + rr * 64 + e0); const f32x4 k = *(const f32x4*)(Ks + rr * 64 + d0);
                    a0 += k * v0.x; a1 += k * v0.y; b0 += k * v1.x; b1 += k * v1.y; an += k * wn[rr]; }
                if ((tid & 63) < 16) *(f32x4*)((wave ? dst1 : dst0) + 4096 + d0) = an;
            } else {
#pragma unroll 4
                for (int rr = 0; rr < 128; ++rr) { const f32x2 v0 = *(const f32x2*)(VW0 + rr * 64 + e0), v1 = *(const f32x2*)(VW1 + rr * 64 + e0); const f32x4 k = *(const f32x4*)(Ks + rr * 64 + d0);
                    a0 += k * v0.x; a1 += k * v0.y; b0 += k * v1.x; b1 += k * v1.y; }
            }
            *(f32x4*)(dst0 + e0 * 64 + d0) = a0; *(f32x4*)(dst0 + (e0 + 1) * 64 + d0) = a1;
            *(f32x4*)(dst1 + e0 * 64 + d0) = b0; *(f32x4*)(dst1 + (e0 + 1) * 64 + d0) = b1;
        }
        __syncthreads();
        } }
    }
}
__device__ __forceinline__ void mlstm_scan(KP P, int vcu, int G) {
    asm volatile("" : "+s"(P)); int tid_l = threadIdx.x; asm volatile("" : "+v"(tid_l)); const int tid = tid_l, lane = tid & 63, wave = __builtin_amdgcn_readfirstlane(tid >> 6); (void)tid; (void)lane; (void)wave;
    const float* DC = (const float*)(P->ws + ML_DC); const float* BEND = (const float*)(P->ws + ML_BEND); const float* MLOC = (const float*)(P->ws + ML_MLOC);
    bf16_t* CST = (bf16_t*)(P->ws + ML_CST); float* NST = (float*)(P->ws + ML_NST); float* MST = (float*)(P->ws + ML_MST);
    for (int it = vcu; it < 144; it += G) {
        const int chain = it / 9, elem = (it % 9) * 512 + tid;
        if (elem < 4160) {
            float C = 0.f, m = 0.f;
            const float* dcp = DC + (size_t)chain * 64 * 4160 + elem; const float* bep = BEND + chain * 64; const float* mlp = MLOC + chain * 64;
            float dcn[4], ben[4], mln[4];
#pragma unroll
            for (int j = 0; j < 4; ++j) { dcn[j] = dcp[(size_t)j * 4160]; ben[j] = bep[j]; mln[j] = mlp[j]; }
#pragma unroll 1
            for (int c0 = 0; c0 < 64; c0 += 4) {
                float dc[4], be[4], ml[4];
#pragma unroll
                for (int j = 0; j < 4; ++j) { dc[j] = dcn[j]; be[j] = ben[j]; ml[j] = mln[j]; }
                if (c0 + 4 < 64) {
#pragma unroll
                    for (int j = 0; j < 4; ++j) { dcn[j] = dcp[(size_t)(c0 + 4 + j) * 4160]; ben[j] = bep[c0 + 4 + j]; mln[j] = mlp[c0 + 4 + j]; } }
#pragma unroll
                for (int j = 0; j < 4; ++j) { const int base = chain * 64 + c0 + j;
                    if (elem < 4096) CST[(size_t)base * 4096 + elem] = (bf16_t)(pk2(C, 0.f) & 0xffffu); else NST[base * 64 + elem - 4096] = C;
                    if (elem == 0) MST[base] = m;
                    const float mn = fmaxf(be[j] + m, ml[j]);
                    C = __expf(be[j] + m - mn) * C + __expf(ml[j] - mn) * dc[j]; m = mn; }
            }
        }
    }
}
__device__ __forceinline__ void mlstm_out(KP P, int l, unsigned char* lds, int vcu, int G) {
    asm volatile("" : "+s"(P)); int tid_l = threadIdx.x; asm volatile("" : "+v"(tid_l)); const int tid = tid_l, lane = tid & 63, wave = __builtin_amdgcn_readfirstlane(tid >> 6); (void)tid; (void)lane; (void)wave;
    const bf16_t* HM = (const bf16_t*)(P->ws + WS_H); bf16_t* Y = (bf16_t*)(P->ws + WS_Y);
    const bf16_t* CST = (const bf16_t*)(P->ws + ML_CST); const float* NST = (const float*)(P->ws + ML_NST); const float* MST = (const float*)(P->ws + ML_MST);
    bf16_t* QS = (bf16_t*)lds; bf16_t* KS = (bf16_t*)(lds + 18432); bf16_t* VT = (bf16_t*)(lds + 36864); bf16_t* CS = (bf16_t*)(lds + 54272);
    float* NS = (float*)(lds + 72704); float* BETA = (float*)(lds + 73216); float* MU = (float*)(lds + 74240); float* EMT = (float*)(lds + 75264); float* INTER = (float*)(lds + 76288);
    float* RDEN = (float*)(lds + 77312); float* HB = (float*)(lds + 78336);
    const int r32 = lane & 31, hi = lane >> 5;
    for (int it = vcu; it < 512; it += G) {
        const int b = it >> 8, h = (it >> 6) & 3, c = it & 63, tok0 = b * SEQ + c * 128;
        const int sb0 = ((b * 2 + 0) * 4 + h) * 64 + c, sb1 = ((b * 2 + 1) * 4 + h) * 64 + (63 - c);
        const bf16_t* hsrc = HM + (size_t)(tok0 + (tid >> 2)) * NINP + h * 64 + (tid & 3) * 16;
        const bf16x8 ho0 = *(const bf16x8*)(hsrc + OFF_MO), ho1 = *(const bf16x8*)(hsrc + OFF_MO + 8);
        GateRaw graw = {0.f, 0.f, 0.f, 0.f}; float mprev_l = 0.f;
        if (wave < 2) { graw = chunk_gates_load(P, tok0, wave, h, lane); mprev_l = MST[wave ? sb1 : sb0]; }
        {   const int r = tid >> 2, q4 = tid & 3; const bf16_t* src = hsrc;
            const bf16x8 q0 = *(const bf16x8*)(src + OFF_MQ), q1 = *(const bf16x8*)(src + OFF_MQ + 8), k0 = *(const bf16x8*)(src + OFF_MK), k1 = *(const bf16x8*)(src + OFF_MK + 8);
            const bf16x8 v0 = *(const bf16x8*)(src + OFF_MV), v1 = *(const bf16x8*)(src + OFF_MV + 8);
            *(bf16x8*)(QS + r * 72 + q4 * 16) = q0; *(bf16x8*)(QS + r * 72 + q4 * 16 + 8) = q1;
            *(bf16x8*)(KS + r * 72 + q4 * 16) = k0; *(bf16x8*)(KS + r * 72 + q4 * 16 + 8) = k1;
#pragma unroll
            for (int i = 0; i < 8; ++i) { VT[(q4 * 16 + i) * 136 + r] = (bf16_t)v0[i]; VT[(q4 * 16 + 8 + i) * 136 + r] = (bf16_t)v1[i]; }
            const int e = tid >> 3, dq = tid & 7;
            *(bf16x8*)(CS + e * 72 + dq * 8) = *(const bf16x8*)(CST + (size_t)sb0 * 4096 + e * 64 + dq * 8);
            *(bf16x8*)(CS + 4608 + e * 72 + dq * 8) = *(const bf16x8*)(CST + (size_t)sb1 * 4096 + e * 64 + dq * 8);
            if (tid < 128) NS[tid] = NST[(tid < 64 ? sb0 : sb1) * 64 + (tid & 63)];
        }
        if (wave < 2) {
            const int dir = wave; float gia, gib, ba, bb; chunk_gates_calc(P, l, graw, dir, h, lane, gia, gib, ba, bb);
            const float mprev = mprev_l;
            const float bta = gia - ba, btb = gib - bb;
            const float pa = wave_scan_max(bta, lane); const float pb = fmaxf(wave_scan_max(btb, lane), __shfl(pa, 63));
            const float mua = fmaxf(pa, mprev), mub = fmaxf(pb, mprev);
            const int ra = dir ? 127 - lane : lane, rb = dir ? 63 - lane : lane + 64;
            BETA[dir * 128 + ra] = bta; BETA[dir * 128 + rb] = btb; MU[dir * 128 + ra] = mua; MU[dir * 128 + rb] = mub;
            EMT[dir * 128 + ra] = expf(-(ba + mua)); EMT[dir * 128 + rb] = expf(-(bb + mub));
            INTER[dir * 128 + ra] = expf(mprev - mua); INTER[dir * 128 + rb] = expf(mprev - mub);
        }
        __syncthreads();
        {   const int dir = wave >> 2, rb = wave & 3, t = 32 * rb + r32;
            bf16x8 qr[4];
#pragma unroll
            for (int ks = 0; ks < 4; ++ks) qr[ks] = *(const bf16x8*)(QS + t * 72 + 16 * ks + 8 * hi);
            const float mu_t = MU[dir * 128 + t], inter_t = INTER[dir * 128 + t];
            f32x16 o0 = {}, o1 = {}; float rowsum = 0.f;
            for (int sb = 0; sb < 4; ++sb) {
                if (dir == 0 ? (sb > rb) : (sb < rb)) continue;
                f32x16 p = {};
#pragma unroll
                for (int ks = 0; ks < 4; ++ks) { const bf16x8 kf = *(const bf16x8*)(KS + (32 * sb + r32) * 72 + 16 * ks + 8 * hi); p = __builtin_amdgcn_mfma_f32_32x32x16_bf16(kf, qr[ks], p, 0, 0, 0); }
#pragma unroll
                for (int rq = 0; rq < 4; ++rq) { const f32x4 bt = *(const f32x4*)(BETA + dir * 128 + 32 * sb + 8 * rq + 4 * hi);
#pragma unroll
                    for (int i = 0; i < 4; ++i) { const int s = 32 * sb + 8 * rq + 4 * hi + i; const bool valid = dir == 0 ? (s <= t) : (s >= t);
                        const float w = valid ? __expf(bt[i] - mu_t) * 0.125f : 0.f; const float v = p[rq * 4 + i] * w; p[rq * 4 + i] = v; rowsum += v; } }
                u32x4 pw0, pw1;
                pw0.x = pk2(p[0], p[1]); pw0.y = pk2(p[2], p[3]); pw0.z = pk2(p[4], p[5]); pw0.w = pk2(p[6], p[7]);
                pw1.x = pk2(p[8], p[9]); pw1.y = pk2(p[10], p[11]); pw1.z = pk2(p[12], p[13]); pw1.w = pk2(p[14], p[15]);
#pragma unroll
                for (int kb = 0; kb < 2; ++kb) { const bf16x8 pa = __builtin_bit_cast(bf16x8, kb ? pw1 : pw0);
#pragma unroll
                    for (int eb = 0; eb < 2; ++eb) { const bf16_t* vp = VT + (32 * eb + r32) * 136 + 32 * sb + 16 * kb + 4 * hi;
                        const s16x4 lo = *(const s16x4*)vp, hi4 = *(const s16x4*)(vp + 8);
                        const bf16x8 vf = {lo[0], lo[1], lo[2], lo[3], hi4[0], hi4[1], hi4[2], hi4[3]};
                        if (eb == 0) o0 = __builtin_amdgcn_mfma_f32_32x32x16_bf16(pa, vf, o0, 0, 0, 0); else o1 = __builtin_amdgcn_mfma_f32_32x32x16_bf16(pa, vf, o1, 0, 0, 0); } }
            }
            float nq = 0.f;
#pragma unroll
            for (int ks = 0; ks < 4; ++ks) { float qf[8]; unpack8(qr[ks], qf); const float* np = NS + dir * 64 + 16 * ks + 8 * hi;
#pragma unroll
                for (int i = 0; i < 8; ++i) nq += qf[i] * np[i];
                u32x4 qw; qw.x = pk2(qf[0] * inter_t, qf[1] * inter_t); qw.y = pk2(qf[2] * inter_t, qf[3] * inter_t); qw.z = pk2(qf[4] * inter_t, qf[5] * inter_t); qw.w = pk2(qf[6] * inter_t, qf[7] * inter_t);
                const bf16x8 qs = __builtin_bit_cast(bf16x8, qw);
                const bf16x8 c0 = *(const bf16x8*)(CS + dir * 4608 + r32 * 72 + 16 * ks + 8 * hi), c1 = *(const bf16x8*)(CS + dir * 4608 + (32 + r32) * 72 + 16 * ks + 8 * hi);
                o0 = __builtin_amdgcn_mfma_f32_32x32x16_bf16(qs, c0, o0, 0, 0, 0); o1 = __builtin_amdgcn_mfma_f32_32x32x16_bf16(qs, c1, o1, 0, 0, 0); }
            float den = rowsum + inter_t * nq; den += __shfl_xor(den, 32);
            const float rden = 1.0f / fmaxf(fabsf(den), EMT[dir * 128 + t]);
            if (hi == 0) RDEN[wave * 32 + r32] = rden;
            LDS_WAIT(); asm volatile("" ::: "memory");
#pragma unroll
            for (int rq = 0; rq < 4; ++rq) { const f32x4 rd = *(const f32x4*)(RDEN + wave * 32 + 8 * rq + 4 * hi);
#pragma unroll
                for (int i = 0; i < 4; ++i) { float* hp = HB + (dir * 128 + 32 * rb + 8 * rq + 4 * hi + i) * 65; hp[r32] = o0[rq * 4 + i] * rd[i]; hp[32 + r32] = o1[rq * 4 + i] * rd[i]; } }
        }
        __syncthreads();
        {   const int r = tid >> 2, q4 = tid & 3; float hv[16]; float ss = 0.f;
#pragma unroll
            for (int i = 0; i < 16; ++i) { hv[i] = HB[r * 65 + q4 * 16 + i] + HB[(128 + r) * 65 + q4 * 16 + i]; ss += hv[i] * hv[i]; }
            ss += __shfl_xor(ss, 1); ss += __shfl_xor(ss, 2);
            const float rstd = rsqrtf(ss * (1.f / 64) + EPS);
            const float* gn = P->in[I_MON] + l * 256 + h * 64 + q4 * 16;
            float ho[16]; unpack8(ho0, ho); unpack8(ho1, ho + 8);
            u32x4 w0, w1; float ov[16];
#pragma unroll
            for (int i = 0; i < 16; ++i) ov[i] = hv[i] * rstd * gn[i] * sigmoid_f(ho[i]);
            w0.x = pk2(ov[0], ov[1]); w0.y = pk2(ov[2], ov[3]); w0.z = pk2(ov[4], ov[5]); w0.w = pk2(ov[6], ov[7]);
            w1.x = pk2(ov[8], ov[9]); w1.y = pk2(ov[10], ov[11]); w1.z = pk2(ov[12], ov[13]); w1.w = pk2(ov[14], ov[15]);
            bf16_t* yp = Y + (size_t)(tok0 + r) * DM + 768 + h * 64 + q4 * 16; *(u32x4*)yp = w0; *(u32x4*)(yp + 8) = w1;
        }
        __syncthreads();
    }
}
__device__ __forceinline__ int xt_off(int row) { return ((row >> 5) * 16 + (row & 15)) * 1040 + ((row >> 4) & 1) * 512; }
__device__ __forceinline__ void xattn_phase(KP P, int l, unsigned char* lds, int vcu, int G, int fixed_u) {
    asm volatile("" : "+s"(P)); int tid_l = threadIdx.x; asm volatile("" : "+v"(tid_l)); const int tid = tid_l, lane = tid & 63, wave = __builtin_amdgcn_readfirstlane(tid >> 6);
    const bf16_t* QX = (const bf16_t*)(P->ws + WS_QX); bf16_t* OX = (bf16_t*)(P->ws + WS_OX);
    const bf16_t* KX = (const bf16_t*)(P->ws + WS_KX); const bf16_t* VXT = (const bf16_t*)(P->ws + WS_VXT);
    const unsigned lds0 = (unsigned)(uintptr_t)lds;
    const int r32 = lane & 31, hi = lane >> 5;
    const unsigned char* kfb = lds + xt_off(r32) + 16 * hi;
    const unsigned char* vfb = lds + xt_off(r32) + 8 * hi;
    for (int u = (fixed_u >= 0 ? fixed_u : vcu); u < 256; u += (fixed_u >= 0 ? 256 : G)) {
        const int b = u >> 7, h = (u >> 5) & 3, qb = u & 31; const int tokw = b * SEQ + qb * 256 + wave * 32;
        const bf16_t* qrow = QX + (size_t)(tokw + r32) * DM + h * 256 + 8 * hi;
        const size_t hb = ((size_t)(l * 2 + b) * 4 + h) * 65536;
        {   const bf16_t* src = KX + hb + (size_t)(wave * 32 + 16 * (lane >> 5)) * 256 + (lane & 31) * 8;
#pragma unroll
            for (int i = 0; i < 16; ++i) attn_body::glds16(src + i * 256, (unsigned)__builtin_amdgcn_readfirstlane(lds0 + (unsigned)(wave * 16 + i) * 1040u));
        }
        bf16x8 qa[4], qn[4]; float ss = 0.f;
#pragma unroll
        for (int j = 0; j < 4; ++j) { qa[j] = *(const bf16x8*)(qrow + 16 * j); qn[j] = *(const bf16x8*)(qrow + 64 + 16 * j); }
        asm volatile("s_waitcnt vmcnt(0)" ::: "memory"); __syncthreads();
        f32x16 p[8];
#pragma unroll
        for (int mb = 0; mb < 8; ++mb) p[mb] = (f32x16){};
#pragma unroll 1
        for (int g = 0; g < 4; ++g) {
#pragma unroll
            for (int j = 0; j < 4; ++j) { float qf[8]; unpack8(qa[j], qf);
#pragma unroll
                for (int i = 0; i < 8; ++i) ss += qf[i] * qf[i];
#pragma unroll
                for (int mb = 0; mb < 8; ++mb) { const bf16x8 kf = *(const bf16x8*)(kfb + 16 * 1040 * mb + 128 * g + 32 * j); p[mb] = __builtin_amdgcn_mfma_f32_32x32x16_bf16(kf, qa[j], p[mb], 0, 0, 0); }
                __builtin_amdgcn_sched_barrier(0); }
#pragma unroll
            for (int j = 0; j < 4; ++j) { qa[j] = qn[j]; if (g < 2) qn[j] = *(const bf16x8*)(qrow + 64 * (g + 2) + 16 * j); }
        }
        asm volatile("s_waitcnt lgkmcnt(0)" ::: "memory"); __syncthreads();
        {   const bf16_t* src = VXT + hb + (size_t)(wave * 32 + 16 * (lane >> 5)) * 256 + (lane & 31) * 8;
#pragma unroll
            for (int i = 0; i < 16; ++i) attn_body::glds16(src + i * 256, (unsigned)__builtin_amdgcn_readfirstlane(lds0 + (unsigned)(wave * 16 + i) * 1040u));
        }
        ss += __shfl_xor(ss, 32);
        const float rstd = rsqrtf(ss * (1.f / 256) + EPS);
        float mx = -INFINITY;
#pragma unroll
        for (int mb = 0; mb < 8; ++mb)
#pragma unroll
            for (int r = 0; r < 16; ++r) mx = fmaxf(mx, p[mb][r]);
        mx = fmaxf(mx, __shfl_xor(mx, 32)); mx *= rstd;
        float lsum = 0.f; u32x4 pw[8][2];
#pragma unroll
        for (int mb = 0; mb < 8; ++mb) {
#pragma unroll
            for (int r = 0; r < 16; ++r) { const float e = __builtin_amdgcn_exp2f(p[mb][r] * rstd - mx); p[mb][r] = e; lsum += e; }
            pw[mb][0].x = pk2(p[mb][0], p[mb][1]); pw[mb][0].y = pk2(p[mb][2], p[mb][3]); pw[mb][0].z = pk2(p[mb][4], p[mb][5]); pw[mb][0].w = pk2(p[mb][6], p[mb][7]);
            pw[mb][1].x = pk2(p[mb][8], p[mb][9]); pw[mb][1].y = pk2(p[mb][10], p[mb][11]); pw[mb][1].z = pk2(p[mb][12], p[mb][13]); pw[mb][1].w = pk2(p[mb][14], p[mb][15]); }
        lsum += __shfl_xor(lsum, 32);
        const float rl = 1.0f / lsum;
        asm volatile("s_waitcnt vmcnt(0)" ::: "memory"); __syncthreads();
        bf16_t* orow = OX + (size_t)(tokw + r32) * DM + h * 256 + 4 * hi;
#pragma unroll 1
        for (int db = 0; db < 8; ++db) { f32x16 o = {};
#pragma unroll
            for (int mb = 0; mb < 8; ++mb)
#pragma unroll
                for (int k2 = 0; k2 < 2; ++k2) { const unsigned char* vp = vfb + 16 * 1040 * db + 64 * mb + 32 * k2;
                    const s16x4 lo = *(const s16x4*)vp, hi4 = *(const s16x4*)(vp + 16); const bf16x8 vf = {lo[0], lo[1], lo[2], lo[3], hi4[0], hi4[1], hi4[2], hi4[3]};
                    o = __builtin_amdgcn_mfma_f32_32x32x16_bf16(vf, __builtin_bit_cast(bf16x8, pw[mb][k2]), o, 0, 0, 0); }
#pragma unroll
            for (int rq = 0; rq < 4; ++rq) { u32x2 w; w.x = pk2(o[rq * 4] * rl, o[rq * 4 + 1] * rl); w.y = pk2(o[rq * 4 + 2] * rl, o[rq * 4 + 3] * rl); *(u32x2*)(orow + db * 32 + 8 * rq) = w; } }
        asm volatile("s_waitcnt lgkmcnt(0)" ::: "memory"); __syncthreads();
    }
}

__device__ __forceinline__ bool static_unit(int M, int N, int G, int c, int i, int& pm, int& pn) {
    const int nM = M / 256, nN = N / 256, nwg = nM * nN; const long L = (long)i * G + c; if (L >= nwg) return false;
    int wgid = (int)L; { const int q = nwg / 8, r = nwg % 8, xcd = wgid % 8, off = wgid / 8; wgid = (xcd < r ? xcd * (q + 1) : r * (q + 1) + (xcd - r) * q) + off; }
    const int nig = 8 * nN, gid = wgid / nig, fm = gid * 8, gsz = (nM - fm) < 8 ? (nM - fm) : 8;
    pm = fm + ((wgid % nig) % gsz); pn = (wgid % nig) / gsz; return true;
}
__device__ __forceinline__ void rstd_prepass(const float* SS, int N, int G, int c, unsigned char* lds) {
    int tid_l = threadIdx.x; asm volatile("" : "+v"(tid_l)); const int tid = tid_l, row = tid >> 1, half = tid & 1;
    float* RS = (float*)(lds + 131072);
    f32x4 a[6], b[6]; bool ok[6];
#pragma unroll
    for (int i = 0; i < 6; ++i) { int pm = 0, pn = 0; ok[i] = static_unit(T, N, G, c, i, pm, pn);
        if (ok[i]) { const f32x4* p = (const f32x4*)(SS + (size_t)(pm * 256 + row) * 16 + half * 8); a[i] = p[0]; b[i] = p[1]; } else { a[i] = (f32x4){0.f, 0.f, 0.f, 0.f}; b[i] = a[i]; } }
#pragma unroll
    for (int i = 0; i < 6; ++i) { float s = ((a[i][0] + a[i][1]) + (a[i][2] + a[i][3])) + ((b[i][0] + b[i][1]) + (b[i][2] + b[i][3])); s += __shfl_xor(s, 1);
        if (ok[i] && half == 0) RS[i * 256 + row] = __builtin_amdgcn_rsqf(s * (1.0f / 1024.0f) + 1e-6f); }
    __syncthreads();
}
__global__ void __launch_bounds__(NTHR, 2) hybrid_fwd(Params Parg) {
    KP P = (KP)__builtin_amdgcn_kernarg_segment_ptr();
    extern __shared__ __attribute__((aligned(16))) unsigned char lds[];
    cg::grid_group grid = cg::this_grid();
    const int tid = threadIdx.x, lane = tid & 63, wave = __builtin_amdgcn_readfirstlane(tid >> 6);
    const int G = gridDim.x, bx = blockIdx.x, vcu = (G % 8 == 0) ? (bx % 8) * (G / 8) + bx / 8 : bx;
    const int gw = vcu * NWAVES + wave, ngw = G * NWAVES;
    unsigned char* ws = P->ws;
    bf16_t* XN = (bf16_t*)(ws + WS_XN); bf16_t* H = (bf16_t*)(ws + WS_H); bf16_t* HM = (bf16_t*)(ws + WS_H); bf16_t* Y = (bf16_t*)(ws + WS_Y);
    PG8_LAS unsigned char* lds3 = (PG8_LAS unsigned char*)lds;
    if (tid < 16) ((volatile unsigned*)(lds + MISC_OFF))[tid] = 0u;
    __syncthreads();
    (void)xcd_barrier_post((unsigned*)(ws + WS_CTL), (volatile LAS unsigned*)(lds3 + MISC_OFF));
#define GSYNC() do { XcdBarrier b_; b_.bar = (unsigned*)(P->ws + WS_CTL); b_.x = xb_xcc_id(); b_.st = (volatile LAS unsigned*)(lds3 + MISC_OFF); xcd_barrier(b_); } while (0)
#define TAILCONV(first_, count_) do { if (G == 256) { if (bx >= 128) convert_items(P, lds, (first_), (count_), bx - 128, 128); } else convert_items(P, lds, (first_), (count_), bx, G); } while (0)
#define WPTR(l, off) ((bf16_t*)(ws + WS_W + (size_t)(l) * W_LAYER + (off)))

    if (PHM & 512) {
        convert_items(P, lds, 0, 2816, vcu, G);
        rope_table((f32x2*)(ws + WS_ROPE), vcu * NTHR + tid, G * NTHR);
        for (int l = 0; l < 2; ++l) norm_rows(P->in[I_MEM], P->in[I_MN] + l * DM, (bf16_t*)(ws + WS_MEMN) + (size_t)l * 512 * DM, 512, vcu, G);
        xb_rows(P->in[I_X], XN, (float*)(ws + WS_SS), T, vcu, G);
    }
    if (G > (1 << 20)) grid.sync();
    GSYNC();
    for (int l = 0; l < 2; ++l) {
        const float* xin = (l == 0) ? P->in[I_X] : P->out;
        {   pg8::Gemm g{XN, WPTR(l, O_W13A), T, 2 * FF, DM}; pg8::StaticOrder S; S.init(T, 2 * FF, G, bx); rstd_prepass((const float*)(ws + WS_SS), 2 * FF, G, bx, lds); pg8::EpiSwiGLU E{H, FF, (const PG8_LAS float*)(lds3 + 131072), 0};
            pg8::gemm_phase<pg8::EpiSwiGLU, pg8::StaticOrder, true, true>(lds3, g, S, E); }
        { const int lb = l * W_ITEMS_LAYER; TAILCONV(lb + (l ? 4224 : 2816), (l ? 2304 : 3712)); TAILCONV(lb + 7552, 512); }
        if (l == 0) { TAILCONV(6528, 1024); TAILCONV(W_ITEMS_LAYER + 6528, 1024); }
        GSYNC();
        {   pg8::Gemm g{H, WPTR(l, O_W2A), T, DM, FF}; pg8::StaticOrder S; S.init(T, DM, G, bx); pg8::EpiResid E{xin, P->out, DM, 0.5f, XN, (float*)(ws + WS_SS)};
            pg8::gemm_phase<pg8::EpiResid, pg8::StaticOrder, true, true>(lds3, g, S, E); }
        GSYNC();
        {   pg8::Gemm g{XN, WPTR(l, O_WIN), T, NINP, DM}; pg8::StaticOrder S; S.init(T, NINP, G, bx); rstd_prepass((const float*)(ws + WS_SS), NINP, G, bx, lds); pg8::EpiStoreBf16 E{HM, NINP, (float*)(ws + WS_GATES), (const PG8_LAS float*)(lds3 + 131072), 0};
            pg8::gemm_phase<pg8::EpiStoreBf16, pg8::StaticOrder, true, true>(lds3, g, S, E); }
        if (l == 0) {
            if (G == 256) { if (bx >= 128 && bx < 224) convert_items(P, lds, 8064, 4224, bx - 128, 96); } else convert_items(P, lds, 8064, 4224, bx, G);
            for (int l2 = 0; l2 < 2; ++l2) {
                pg8::Gemm g{(const bf16_t*)(ws + WS_MEMN) + (size_t)l2 * 512 * DM, WPTR(l2, O_WKV), 512, 2 * DM, DM}; pg8::StaticOrder S; S.init(512, 2 * DM, G, (bx + 240 * G - 224 - l2 * 16) % G);
                pg8::EpiF32 E{(float*)(ws + WS_KVRAW) + (size_t)l2 * 512 * 2048, 2048};
                pg8::gemm_phase<pg8::EpiF32, pg8::StaticOrder, true, true>(lds3, g, S, E); }
        } else TAILCONV(l * W_ITEMS_LAYER + 8064, 4224);
        GSYNC();
        if (l == 0) memprep(P, vcu, G);
        if (PHM & 2) conv_phase(P, l, lds, vcu, G);
        if (PHM & 4) mlstm_local(P, l, lds, vcu, G);
        GSYNC();
        if (PHM & 8) mlstm_scan(P, vcu, G);
        if (PHM & 16) {
            const attn_body::bf16* Qp = (const attn_body::bf16*)(HM + OFF_Q); const attn_body::bf16* Kp = (const attn_body::bf16*)(HM + OFF_K); const attn_body::bf16* Vp = (const attn_body::bf16*)(HM + OFF_V);
            bool nomax;
            {   const float gq = wave_max(fabsf(P->in[I_AQN][l * 64 + (threadIdx.x & 63)])), gk = wave_max(fabsf(P->in[I_AKN][l * 64 + (threadIdx.x & 63)]));
                nomax = __builtin_amdgcn_readfirstlane((int)(64.0f * attn_body::C2 * gq * gk * 1.02f <= 48.0f)) != 0; }
#define ATTN_UNIT(b_, h_, qb_) do { if (nomax) attn_body::attn_unit<8, true>((b_), (h_), (qb_), Qp, Kp, Vp, (attn_body::bf16*)Y, (char*)lds, P->in[I_AQN] + l * 64, (const float*)(P->ws + WS_ROPE)); \
                                    else attn_body::attn_unit<8, false>((b_), (h_), (qb_), Qp, Kp, Vp, (attn_body::bf16*)Y, (char*)lds, P->in[I_AQN] + l * 64, (const float*)(P->ws + WS_ROPE)); } while (0)
            __syncthreads();
            if (G == 256) { const int xcd = vcu >> 5, local = vcu & 31, pair = xcd >> 1;
                for (int i = 0; i < 2; ++i) { const int idx = (xcd & 1) * 64 + local * 2 + i; ATTN_UNIT(pair >> 1, (pair & 1) * 4 + (idx >> 5), idx & 31); } }
            else for (int u = vcu; u < 512; u += G) { const int pair = u >> 7, idx = u & 127; ATTN_UNIT(pair >> 1, (pair & 1) * 4 + (idx >> 5), idx & 31); }
            asm volatile("s_waitcnt vmcnt(0)" ::: "memory"); __syncthreads();
        }
        GSYNC();
        if (PHM & 32) mlstm_out(P, l, lds, vcu, G);
        GSYNC();
        {   pg8::Gemm g{Y, WPTR(l, O_WOUT), T, DM, DM}; pg8::StaticOrder S; S.init(T, DM, G, bx); pg8::EpiResid E{P->out, P->out, DM, 1.0f, XN, (float*)(ws + WS_SS)};
            pg8::gemm_phase<pg8::EpiResid, pg8::StaticOrder, true, true>(lds3, g, S, E); }
        GSYNC();
        {   pg8::Gemm g{XN, WPTR(l, O_WQ), T, DM, DM}; pg8::StaticOrder S; S.init(T, DM, G, bx); rstd_prepass((const float*)(ws + WS_SS), DM, G, bx, lds); pg8::EpiStoreBf16 E{(bf16_t*)(ws + WS_QX), DM, nullptr, (const PG8_LAS float*)(lds3 + 131072), 0};
            pg8::gemm_phase<pg8::EpiStoreBf16, pg8::StaticOrder, true, true>(lds3, g, S, E); }
        {
            int xu = -1;
            if (G == 256) {
                const int nwg = 256, q8 = nwg / 8; int wgid = bx; wgid = (wgid % 8) * q8 + wgid / 8;
                const int nig = 8 * 4, gid = wgid / nig, fm = gid * 8; const int upm = fm + ((wgid % nig) % 8), upn = (wgid % nig) / 8;
                xu = __builtin_amdgcn_readfirstlane(((upm >> 5) << 7) | (upn << 5) | (upm & 31)); }
            else GSYNC();
            xattn_phase(P, l, lds, vcu, G, xu); }
        GSYNC();
        {   pg8::Gemm g{(const bf16_t*)(ws + WS_OX), WPTR(l, O_WO), T, DM, DM}; pg8::StaticOrder S; S.init(T, DM, G, bx); pg8::EpiResid E{P->out, P->out, DM, 1.0f, XN, (float*)(ws + WS_SS)};
            pg8::gemm_phase<pg8::EpiResid, pg8::StaticOrder, true, true>(lds3, g, S, E); }
        GSYNC();
        {   pg8::Gemm g{XN, WPTR(l, O_W13B), T, 2 * FF, DM}; pg8::StaticOrder S; S.init(T, 2 * FF, G, bx); rstd_prepass((const float*)(ws + WS_SS), 2 * FF, G, bx, lds); pg8::EpiSwiGLU E{H, FF, (const PG8_LAS float*)(lds3 + 131072), 0};
            pg8::gemm_phase<pg8::EpiSwiGLU, pg8::StaticOrder, true, true>(lds3, g, S, E); }
        if (l == 0) TAILCONV(W_ITEMS_LAYER, 2816 + 1408);
        GSYNC();
        {   pg8::Gemm g{H, WPTR(l, O_W2B), T, DM, FF}; pg8::StaticOrder S; S.init(T, DM, G, bx); pg8::EpiResid E{P->out, P->out, DM, 0.5f, XN, (float*)(ws + WS_SS)};
            pg8::gemm_phase<pg8::EpiResid, pg8::StaticOrder, true, true>(lds3, g, S, E); }
        if (l == 0) GSYNC();
    }
}
}

extern "C" void kernel_launch(void* const* d_in, const int* in_sizes, int n_in, void* d_out, int out_size, void* d_ws, size_t ws_size, hipStream_t stream) {
    static int grid = 0;
    if (grid == 0) {
        if (n_in != 26 || ws_size < mk::WS_TOTAL) { fprintf(stderr, "kernel_launch: expected 26 inputs and >= %zu bytes of workspace (got %d, %zu)\n", (size_t)mk::WS_TOTAL, n_in, ws_size); grid = -1; return; }
        int dev = 0, cus = 0, per_cu = 0;
        hipGetDevice(&dev); hipDeviceGetAttribute(&cus, hipDeviceAttributeMultiprocessorCount, dev);
        if (hipFuncSetAttribute((const void*)mk::hybrid_fwd, hipFuncAttributeMaxDynamicSharedMemorySize, mk::LDS_BYTES) != hipSuccess) { fprintf(stderr, "kernel_launch: hipFuncSetAttribute failed\n"); grid = -1; return; }
        if (hipOccupancyMaxActiveBlocksPerMultiprocessor(&per_cu, (const void*)mk::hybrid_fwd, mk::NTHR, mk::LDS_BYTES) != hipSuccess || per_cu < 1) { fprintf(stderr, "kernel_launch: occupancy query says %d blocks per CU\n", per_cu); (void)hipGetLastError(); per_cu = 1; }
        grid = cus * (per_cu > 1 ? 1 : per_cu);
    }
    if (grid < 0) return;
    if (hipMemsetAsync((char*)d_ws + mk::WS_CTL, 0, mk::CTL_BYTES, stream) != hipSuccess) { fprintf(stderr, "kernel_launch: memset of the barrier words failed\n"); return; }
    mk::Params p{};
    for (int i = 0; i < 26; ++i) p.in[i] = (const float*)d_in[i];
    p.out = (float*)d_out; p.ws = (unsigned char*)d_ws;
    void* args[] = {&p};
    hipError_t e = hipLaunchCooperativeKernel((const void*)mk::hybrid_fwd, dim3(grid), dim3(mk::NTHR), args, mk::LDS_BYTES, stream);
    if (e != hipSuccess) fprintf(stderr, "kernel_launch: cooperative launch failed: %s (grid %d)\n", hipGetErrorString(e), grid);
}
```

```cpp
#include <hip/hip_runtime.h>
#include <hip/hip_cooperative_groups.h>
#include <hip/hip_bf16.h>
#include <cstdio>
#include <cstdint>
#include <cmath>
namespace cg = cooperative_groups;
#define LAS __attribute__((address_space(3)))
namespace pg8 {
#define PG8_LAS __attribute__((address_space(3)))
typedef unsigned short bf16_t;
typedef short bf16x8 __attribute__((ext_vector_type(8)));
typedef float f32x4 __attribute__((ext_vector_type(4)));
typedef unsigned u32x4 __attribute__((ext_vector_type(4)));
constexpr int BM = 256, BK = 64, HALF = 128, HTB = HALF * BK * 2  , STAGE_BYTES = 8 * HTB, NXCD = 8, WGM = 8;

__host__ __device__ __forceinline__ int lds_byte(int r, int c) { const int st = (r >> 4) * 2 + (c >> 5), rr = r & 15, cc = c & 31, ob = rr * 64 + cc * 2; return st * 1024 + (ob ^ (((ob >> 9) & 1) << 5)); }
__host__ __device__ __forceinline__ void stage_rc(int b, int& R, int& C) { const int st = b / 1024, sb = b % 1024, swz = sb ^ (((sb >> 9) & 1) << 5); R = (st >> 1) * 16 + swz / 64; C = (st & 1) * 32 + (swz % 64) / 2; }
__host__ __device__ __forceinline__ int perm32(int rho) { const int n = rho >> 4, i = rho & 15; return 8 * (i >> 2) + 4 * n + (i & 3); }

struct Unit { int pm, pn; };
struct Gemm { const bf16_t* A; const bf16_t* Bt; int M, N, K; };

struct StaticOrder {
    int nM, nN, nwg, G, c;
    __host__ __device__ void init(int M, int N, int G_, int c_) { nM = M / BM; nN = N / BM; nwg = nM * nN; G = G_; c = c_; }
    __host__ __device__ bool next(int i, Unit& u) const {
        const long L = (long)i * G + c; if (L >= nwg) return false;
        int wgid = (int)L; { const int q = nwg / NXCD, r = nwg % NXCD, xcd = wgid % NXCD, off = wgid / NXCD; wgid = (xcd < r ? xcd * (q + 1) : r * (q + 1) + (xcd - r) * q) + off; }
        const int nig = WGM * nN, gid = wgid / nig, fm = gid * WGM, gsz = (nM - fm) < WGM ? (nM - fm) : WGM;
        u.pm = fm + ((wgid % nig) % gsz); u.pn = (wgid % nig) / gsz; return true;
    }
    __device__ __forceinline__ void a_ready(const Unit&) const {}
    __device__ __forceinline__ void done(const Unit&) const {}
};

__device__ __forceinline__ unsigned cvt_pk_bf16(float lo, float hi) { unsigned r; asm volatile("v_cvt_pk_bf16_f32 %0, %1, %2" : "=v"(r) : "v"(lo), "v"(hi)); return r; }
__device__ __forceinline__ float silu_f(float a) { return a * __builtin_amdgcn_rcpf(1.0f + __expf(-a)); }

__device__ __forceinline__ float row_rstd(const float* SS, int row) {
    const f32x4* p = (const f32x4*)(SS + (size_t)row * 16); const f32x4 a = p[0], b = p[1], c = p[2], d = p[3];
    const float s = ((a[0] + a[1]) + (a[2] + a[3])) + ((b[0] + b[1]) + (b[2] + b[3])) + ((c[0] + c[1]) + (c[2] + c[3])) + ((d[0] + d[1]) + (d[2] + d[3]));
    return __builtin_amdgcn_rsqf(s * (1.0f / 1024.0f) + 1e-6f);
}
#define ROW_RSTD8(rs, SS, row0, fq) do { f32x4 part_[2][4]; \
    _Pragma("unroll") for (int ai_ = 0; ai_ < 2; ++ai_) _Pragma("unroll") for (int m_ = 0; m_ < 4; ++m_) part_[ai_][m_] = *(const f32x4*)((SS) + (size_t)((row0) + ai_ * HALF + m_ * 16) * 16 + 4 * (fq)); \
    _Pragma("unroll") for (int ai_ = 0; ai_ < 2; ++ai_) _Pragma("unroll") for (int m_ = 0; m_ < 4; ++m_) { float s_ = (part_[ai_][m_][0] + part_[ai_][m_][1]) + (part_[ai_][m_][2] + part_[ai_][m_][3]); \
        s_ += __shfl_xor(s_, 16); s_ += __shfl_xor(s_, 32); rs[ai_][m_] = __builtin_amdgcn_rsqf(s_ * (1.0f / 1024.0f) + 1e-6f); } } while (0)
struct EpiStoreBf16 {
    static constexpr bool PERM = true, AFTER_DRAIN = false;
    bf16_t* O; int ldc; float* gates; const PG8_LAS float* RS; mutable int ui;
    __device__ __forceinline__ void operator()(const f32x4 (&acc)[2][2][4][2], const Unit& u, int wr, int wc, int fr, int fq) const {
        const int row0 = u.pm * BM + wr * 64 + fr, col0 = u.pn * BM + wc * 32 + 8 * fq;
        float rsv[2][4];
#pragma unroll
        for (int ai = 0; ai < 2; ++ai)
#pragma unroll
            for (int m = 0; m < 4; ++m) rsv[ai][m] = RS[ui * 256 + ai * HALF + wr * 64 + m * 16 + fr];
        ++ui;
#pragma unroll
        for (int ai = 0; ai < 2; ++ai)
#pragma unroll
            for (int m = 0; m < 4; ++m) { const int row = row0 + ai * HALF + m * 16; bf16_t* rowp = O + (size_t)row * ldc + col0; const float rs = rsv[ai][m];
#pragma unroll
                for (int bj = 0; bj < 2; ++bj) { const f32x4 v0 = acc[ai][bj][m][0] * rs, v1 = acc[ai][bj][m][1] * rs;
                    u32x4 w; w.x = cvt_pk_bf16(v0[0], v0[1]); w.y = cvt_pk_bf16(v0[2], v0[3]); w.z = cvt_pk_bf16(v1[0], v1[1]); w.w = cvt_pk_bf16(v1[2], v1[3]);
                    *(u32x4*)(rowp + bj * HALF) = w; }
                if (gates != nullptr && u.pn == 9 && wc == 0 && fq < 2) { float* gp = gates + (size_t)row * 16 + 8 * fq; *(f32x4*)gp = acc[ai][0][m][0] * rs; *(f32x4*)(gp + 4) = acc[ai][0][m][1] * rs; }
            }
    }
};
struct EpiSwiGLU {
    static constexpr bool PERM = true, AFTER_DRAIN = false;
    bf16_t* H; int ldh; const PG8_LAS float* RS; mutable int ui;
    __device__ __forceinline__ void operator()(const f32x4 (&acc)[2][2][4][2], const Unit& u, int wr, int wc, int fr, int fq) const {
        const int row0 = u.pm * BM + wr * 64 + fr, col0 = u.pn * HALF + wc * 32 + 8 * fq;
        float rsv[2][4];
#pragma unroll
        for (int ai = 0; ai < 2; ++ai)
#pragma unroll
            for (int m = 0; m < 4; ++m) rsv[ai][m] = RS[ui * 256 + ai * HALF + wr * 64 + m * 16 + fr];
        ++ui;
#pragma unroll
        for (int ai = 0; ai < 2; ++ai)
#pragma unroll
            for (int m = 0; m < 4; ++m) { const int row = row0 + ai * HALF + m * 16; bf16_t* rowp = H + (size_t)row * ldh + col0; const float rs = rsv[ai][m];
                const float rs2 = rs * -1.4426950408889634f, rsq = rs * rs;
                f32x4 o0, o1;
                {   const f32x4 a = acc[ai][0][m][0], b = acc[ai][1][m][0]; const f32x4 t = a * rs2; f32x4 ex;
                    ex[0] = __builtin_amdgcn_exp2f(t[0]); ex[1] = __builtin_amdgcn_exp2f(t[1]); ex[2] = __builtin_amdgcn_exp2f(t[2]); ex[3] = __builtin_amdgcn_exp2f(t[3]);
                    const f32x4 d = ex + 1.0f; f32x4 r; r[0] = __builtin_amdgcn_rcpf(d[0]); r[1] = __builtin_amdgcn_rcpf(d[1]); r[2] = __builtin_amdgcn_rcpf(d[2]); r[3] = __builtin_amdgcn_rcpf(d[3]);
                    o0 = (a * b) * (r * rsq); }
                {   const f32x4 a = acc[ai][0][m][1], b = acc[ai][1][m][1]; const f32x4 t = a * rs2; f32x4 ex;
                    ex[0] = __builtin_amdgcn_exp2f(t[0]); ex[1] = __builtin_amdgcn_exp2f(t[1]); ex[2] = __builtin_amdgcn_exp2f(t[2]); ex[3] = __builtin_amdgcn_exp2f(t[3]);
                    const f32x4 d = ex + 1.0f; f32x4 r; r[0] = __builtin_amdgcn_rcpf(d[0]); r[1] = __builtin_amdgcn_rcpf(d[1]); r[2] = __builtin_amdgcn_rcpf(d[2]); r[3] = __builtin_amdgcn_rcpf(d[3]);
                    o1 = (a * b) * (r * rsq); }
                u32x4 w; w.x = cvt_pk_bf16(o0[0], o0[1]); w.y = cvt_pk_bf16(o0[2], o0[3]); w.z = cvt_pk_bf16(o1[0], o1[1]); w.w = cvt_pk_bf16(o1[2], o1[3]);
                *(u32x4*)rowp = w; }
    }
};
struct EpiResid {
    static constexpr bool PERM = true, AFTER_DRAIN = false;
    const float* base; float* out; int ldc; float scale; bf16_t* XB; float* SS;
    __device__ __forceinline__ void operator()(const f32x4 (&acc)[2][2][4][2], const Unit& u, int wr, int wc, int fr, int fq) const {
        const int row0 = u.pm * BM + wr * 64 + fr, col0 = u.pn * BM + wc * 32 + 8 * fq;
        f32x4 xq[2][2][2][2];
#define EPR_LOAD(g_) do { _Pragma("unroll") for (int mm = 0; mm < 2; ++mm) { const size_t off_ = (size_t)(row0 + ((g_) >> 1) * HALF + (((g_) & 1) * 2 + mm) * 16) * ldc + col0; \
            _Pragma("unroll") for (int bj = 0; bj < 2; ++bj) { xq[(g_) & 1][mm][bj][0] = *(const f32x4*)(base + off_ + bj * HALF); xq[(g_) & 1][mm][bj][1] = *(const f32x4*)(base + off_ + bj * HALF + 4); } } } while (0)
        EPR_LOAD(0);
#pragma unroll
        for (int h8 = 0; h8 < 4; ++h8) { const int ai = h8 >> 1, m0 = (h8 & 1) * 2;
            if (h8 < 3) EPR_LOAD(h8 + 1);
            __builtin_amdgcn_sched_barrier(0);
#pragma unroll
            for (int mm = 0; mm < 2; ++mm) { const int m = m0 + mm; const int row = row0 + ai * HALF + m * 16; const size_t off = (size_t)row * ldc + col0; float ss = 0.f;
#pragma unroll
                for (int bj = 0; bj < 2; ++bj) {
                    const f32x4 x0 = xq[h8 & 1][mm][bj][0] + acc[ai][bj][m][0] * scale, x1 = xq[h8 & 1][mm][bj][1] + acc[ai][bj][m][1] * scale;
                    *(f32x4*)(out + off + bj * HALF) = x0; *(f32x4*)(out + off + bj * HALF + 4) = x1;
                    ss += ((x0[0] * x0[0] + x0[1] * x0[1]) + (x0[2] * x0[2] + x0[3] * x0[3])) + ((x1[0] * x1[0] + x1[1] * x1[1]) + (x1[2] * x1[2] + x1[3] * x1[3]));
                    u32x4 w; w.x = cvt_pk_bf16(x0[0], x0[1]); w.y = cvt_pk_bf16(x0[2], x0[3]); w.z = cvt_pk_bf16(x1[0], x1[1]); w.w = cvt_pk_bf16(x1[2], x1[3]);
                    *(u32x4*)(XB + off + bj * HALF) = w; }
                ss += __shfl_xor(ss, 16); ss += __shfl_xor(ss, 32);
                if (fq == 0) SS[(size_t)row * 16 + u.pn * 4 + wc] = ss; }
        }
#undef EPR_LOAD
    }
};
struct EpiF32 {
    static constexpr bool PERM = true, AFTER_DRAIN = false;
    float* out; int ldc;
    __device__ __forceinline__ void operator()(const f32x4 (&acc)[2][2][4][2], const Unit& u, int wr, int wc, int fr, int fq) const {
        const int row0 = u.pm * BM + wr * 64 + fr, col0 = u.pn * BM + wc * 32 + 8 * fq;
#pragma unroll
        for (int ai = 0; ai < 2; ++ai)
#pragma unroll
            for (int m = 0; m < 4; ++m) { const size_t off = (size_t)(row0 + ai * HALF + m * 16) * ldc + col0;
#pragma unroll
                for (int bj = 0; bj < 2; ++bj) { *(f32x4*)(out + off + bj * HALF) = acc[ai][bj][m][0]; *(f32x4*)(out + off + bj * HALF + 4) = acc[ai][bj][m][1]; } }
    }
};
template <class Epi, class Sched, bool ALIGN_EPI = false, bool SP2 = false>
__device__ __forceinline__ void gemm_phase(PG8_LAS unsigned char* lds, const Gemm g, const Sched& S, const Epi& E) {
    int tid_l = threadIdx.x; asm volatile("" : "+v"(tid_l)); const int tid = tid_l, wid = __builtin_amdgcn_readfirstlane(tid >> 6), lane = tid & 63, wr = wid >> 2, wc = wid & 3, fr = lane & 15, fq = lane >> 4;
    const int K = g.K, nt = K / BK;
    unsigned voffA[2], voffB[2];
#pragma unroll
    for (int i = 0; i < 2; ++i) { int R, C; stage_rc(tid * 16 + i * 8192, R, C); const int Rb = Epi::PERM ? ((R & ~31) + perm32(R & 31)) : R;
        voffA[i] = (unsigned)(R * K + C) * 2u; voffB[i] = (unsigned)(Rb * K + C) * 2u; }
    const size_t kstep = (size_t)(BK * 2);
    const size_t hstep = (size_t)HALF * K * 2;
    const size_t tstep = 2 * hstep;
    const unsigned ldsw = (unsigned)wid * 1024u;
    const int aoff = lds_byte(wr * 64 + fr, fq * 8), boff = lds_byte(wc * 32 + fr, fq * 8);
#define PG8_SA(b, h) (((b) * 2 + (h)) * HTB)
#define PG8_SB(b, h) ((4 + (b) * 2 + (h)) * HTB)
#define PG8_STAGE(bufoff, gbase, voff) do { _Pragma("unroll") for (int _i = 0; _i < 2; ++_i) \
        __builtin_amdgcn_global_load_lds((const unsigned*)((const char*)(gbase) + (voff)[_i]), (PG8_LAS unsigned*)(lds + (bufoff) + ldsw + _i * 8192), 16, 0, 0); } while (0)
#define PG8_LDA(dst, b, h) do { _Pragma("unroll") for (int m = 0; m < 4; ++m) _Pragma("unroll") for (int k = 0; k < 2; ++k) dst[m][k] = *(const PG8_LAS bf16x8*)(lds + PG8_SA(b, h) + aoff + m * 2048 + k * 1024); } while (0)
#define PG8_LDB(dst, b, h) do { _Pragma("unroll") for (int n = 0; n < 2; ++n) _Pragma("unroll") for (int k = 0; k < 2; ++k) dst[n][k] = *(const PG8_LAS bf16x8*)(lds + PG8_SB(b, h) + boff + n * 2048 + k * 1024); } while (0)
#define PG8_MMA(ai, bj, At, Bt) do { __builtin_amdgcn_s_setprio(1); _Pragma("unroll") for (int m = 0; m < 4; ++m) _Pragma("unroll") for (int n = 0; n < 2; ++n) _Pragma("unroll") for (int k = 0; k < 2; ++k) \
        acc[ai][bj][m][n] = __builtin_amdgcn_mfma_f32_16x16x32_bf16(Bt[n][k], At[m][k], acc[ai][bj][m][n], 0, 0, 0); __builtin_amdgcn_s_setprio(0); } while (0)
#define PG8_WAIT_V(n) asm volatile("s_waitcnt vmcnt(" #n ")" ::: "memory")
#define PG8_WAIT_L(n) asm volatile("s_waitcnt lgkmcnt(" #n ")" ::: "memory")
#define PG8_BAR __builtin_amdgcn_s_barrier()
#define PG8_SCHED __builtin_amdgcn_sched_barrier(0)
    Unit cur, nxt; int ui = 0;
    if (!S.next(0, cur)) return;
    f32x4 acc[2][2][4][2];
#pragma unroll
    for (int a = 0; a < 2; ++a)
#pragma unroll
        for (int b = 0; b < 2; ++b)
#pragma unroll
            for (int m = 0; m < 4; ++m)
#pragma unroll
                for (int n = 0; n < 2; ++n) acc[a][b][m][n] = (f32x4){0.f, 0.f, 0.f, 0.f};
    bf16x8 At[4][2], B0[2][2], B1[2][2];
    const char* cA = (const char*)g.A + (size_t)cur.pm * tstep; const char* cB = (const char*)g.Bt + (size_t)cur.pn * tstep;
    S.a_ready(cur);
    if constexpr (SP2) {
        PG8_STAGE(PG8_SB(0, 0), cB, voffB); PG8_STAGE(PG8_SB(0, 1), cB + hstep, voffB); PG8_STAGE(PG8_SA(0, 0), cA, voffA); PG8_STAGE(PG8_SA(0, 1), cA + hstep, voffA);
        if (wr == 1) PG8_BAR;
        PG8_WAIT_V(2); PG8_BAR;
        PG8_STAGE(PG8_SB(1, 0), cB + kstep, voffB); PG8_STAGE(PG8_SA(1, 0), cA + kstep, voffA); PG8_STAGE(PG8_SB(1, 1), cB + hstep + kstep, voffB);
        PG8_WAIT_V(6); PG8_BAR;
    } else {
        PG8_STAGE(PG8_SB(0, 0), cB, voffB); PG8_STAGE(PG8_SA(0, 0), cA, voffA); PG8_STAGE(PG8_SB(0, 1), cB + hstep, voffB); PG8_STAGE(PG8_SA(0, 1), cA + hstep, voffA);
        if (wr == 1) PG8_BAR;
        PG8_WAIT_V(4); PG8_BAR;
        PG8_STAGE(PG8_SB(1, 0), cB + kstep, voffB); PG8_STAGE(PG8_SA(1, 0), cA + kstep, voffA); PG8_STAGE(PG8_SB(1, 1), cB + hstep + kstep, voffB);
        PG8_WAIT_V(6); PG8_BAR;
    }
    for (;;) {
        const bool has_next = S.next(ui + 1, nxt);
        const char* nA = has_next ? (const char*)g.A + (size_t)nxt.pm * tstep : cA; const char* nB = has_next ? (const char*)g.Bt + (size_t)nxt.pn * tstep : cB;
        for (int t = 0; t < nt; t += 2) {
            const bool last = (t == nt - 2);
            const char* a1 = cA + (size_t)(t + 1) * kstep;
            const char* a2 = last ? nA : cA + (size_t)(t + 2) * kstep; const char* b2 = last ? nB : cB + (size_t)(t + 2) * kstep;
            const char* a3 = a2 + kstep; const char* b3 = b2 + kstep;
            if (last && has_next) S.a_ready(nxt);
            if constexpr (SP2) {
            PG8_LDB(B0, 0, 0); PG8_LDB(B1, 0, 1); PG8_SCHED; PG8_LDA(At, 0, 0); PG8_STAGE(PG8_SA(1, 1), a1 + hstep, voffA);
            PG8_WAIT_V(8); PG8_WAIT_L(0); PG8_BAR; PG8_MMA(0, 0, At, B0); PG8_MMA(0, 1, At, B1); PG8_BAR; PG8_SCHED;
            PG8_LDA(At, 0, 1); PG8_STAGE(PG8_SB(0, 0), b2, voffB); PG8_STAGE(PG8_SB(0, 1), b2 + hstep, voffB); PG8_STAGE(PG8_SA(0, 0), a2, voffA);
            PG8_WAIT_V(8); PG8_WAIT_L(0); PG8_BAR; PG8_MMA(1, 0, At, B0); PG8_MMA(1, 1, At, B1); PG8_BAR; PG8_SCHED;
            PG8_LDB(B0, 1, 0); PG8_LDB(B1, 1, 1); PG8_SCHED; PG8_LDA(At, 1, 0); PG8_STAGE(PG8_SA(0, 1), a2 + hstep, voffA);
            PG8_WAIT_V(8); PG8_WAIT_L(0); PG8_BAR; PG8_MMA(0, 0, At, B0); PG8_MMA(0, 1, At, B1); PG8_BAR; PG8_SCHED;
            PG8_LDA(At, 1, 1); PG8_STAGE(PG8_SB(1, 0), b3, voffB); PG8_STAGE(PG8_SB(1, 1), b3 + hstep, voffB); PG8_STAGE(PG8_SA(1, 0), a3, voffA);
            PG8_WAIT_V(8); PG8_WAIT_L(0); PG8_BAR; PG8_MMA(1, 0, At, B0); PG8_MMA(1, 1, At, B1); PG8_BAR; PG8_SCHED;
            } else {
            PG8_LDB(B0, 0, 0); PG8_SCHED; PG8_LDA(At, 0, 0); PG8_STAGE(PG8_SA(1, 1), a1 + hstep, voffA);
            PG8_WAIT_L(8); PG8_BAR; PG8_WAIT_L(0); PG8_MMA(0, 0, At, B0); PG8_BAR; PG8_SCHED;
            PG8_LDB(B1, 0, 1); PG8_STAGE(PG8_SB(0, 0), b2, voffB);
            PG8_BAR; PG8_WAIT_L(0); PG8_MMA(0, 1, At, B1); PG8_BAR;
            PG8_LDA(At, 0, 1); PG8_STAGE(PG8_SA(0, 0), a2, voffA);
            PG8_BAR; PG8_WAIT_L(0); PG8_MMA(1, 0, At, B0); PG8_BAR; PG8_SCHED;
            PG8_STAGE(PG8_SB(0, 1), b2 + hstep, voffB);
            PG8_WAIT_V(6); PG8_BAR; PG8_MMA(1, 1, At, B1); PG8_BAR;
            PG8_LDB(B0, 1, 0); PG8_SCHED; PG8_LDA(At, 1, 0); PG8_STAGE(PG8_SA(0, 1), a2 + hstep, voffA);
            PG8_WAIT_L(8); PG8_BAR; PG8_WAIT_L(0); PG8_MMA(0, 0, At, B0); PG8_BAR; PG8_SCHED;
            PG8_LDB(B1, 1, 1); PG8_STAGE(PG8_SB(1, 0), b3, voffB);
            PG8_BAR; PG8_WAIT_L(0); PG8_MMA(0, 1, At, B1); PG8_BAR;
            PG8_LDA(At, 1, 1); PG8_STAGE(PG8_SA(1, 0), a3, voffA);
            PG8_BAR; PG8_WAIT_L(0); PG8_MMA(1, 0, At, B0); PG8_BAR; PG8_SCHED;
            PG8_STAGE(PG8_SB(1, 1), b3 + hstep, voffB);
            PG8_WAIT_V(6); PG8_BAR; PG8_MMA(1, 1, At, B1); PG8_BAR;
            }
        }
        if constexpr (ALIGN_EPI) { if (wr == 0) PG8_BAR; }
        if constexpr (!Epi::AFTER_DRAIN) { E(acc, cur, wr, wc, fr, fq); S.done(cur); }
        if (!has_next) break;
#pragma unroll
        for (int a = 0; a < 2; ++a)
#pragma unroll
            for (int b = 0; b < 2; ++b)
#pragma unroll
                for (int m = 0; m < 4; ++m)
#pragma unroll
                    for (int n = 0; n < 2; ++n) acc[a][b][m][n] = (f32x4){0.f, 0.f, 0.f, 0.f};
        cur = nxt; cA = nA; cB = nB; ++ui;
        if constexpr (ALIGN_EPI) { if (wr == 1) PG8_BAR; }
    }
    PG8_WAIT_V(0);
    if constexpr (!ALIGN_EPI) { if (wr == 0) PG8_BAR; }
    PG8_BAR;
    if constexpr (Epi::AFTER_DRAIN) { E.fused(acc, cur, wr, wc, fr, fq, lds, wid, lane); S.done(cur); }
#undef PG8_SA
#undef PG8_SB
#undef PG8_STAGE
#undef PG8_LDA
#undef PG8_LDB
#undef PG8_MMA
#undef PG8_WAIT_V
#undef PG8_WAIT_L
#undef PG8_BAR
#undef PG8_SCHED
}
}
namespace attn_body {
using bf16=__hip_bfloat16;
using bf16x8=__attribute__((ext_vector_type(8)))short;
using s16x4=__attribute__((ext_vector_type(4)))short;
using f32x16=__attribute__((ext_vector_type(16)))float;
using u32x4=__attribute__((ext_vector_type(4)))unsigned;
using f32x4q=__attribute__((ext_vector_type(4)))float;
constexpr int SEQ=8192,D=64,QP=2560,KP=2560,OP=1024;
constexpr int NW=8,QBLK=32,QB=QBLK*NW,KVBLK=64,NQB=SEQ/QB;
constexpr int ATTN_UNIT_ROWS=QB;
__device__ __forceinline__ int crow(int r,int hi){return (r&3)+8*(r>>2)+4*hi;}
#define SBAR() __builtin_amdgcn_sched_barrier(0)
__device__ __forceinline__ void cmask(f32x16&p0,f32x16&p1,int jb,int qrel,int hi){
  const float NEG=-INFINITY; int kb=64*jb+4*hi;
  #pragma unroll
  for(int r=0;r<16;++r){int kv=kb+(r&3)+8*(r>>2); if(kv>qrel)p0[r]=NEG; if(kv+32>qrel)p1[r]=NEG;}
}

constexpr int NSLOT=3, SLOTB=8192;
constexpr int LDS_K=0, LDS_V=NSLOT*SLOTB, LDS_WS=2*NSLOT*SLOTB, LDS_OST=LDS_WS+NW*64*4, LDS_BYTES=LDS_OST+NW*4096;
constexpr float C2=0.125f*1.4426950408889634f;
__device__ __forceinline__ void glds16(const void*gsrc,unsigned lds_dst){unsigned keep;
  asm volatile("s_mov_b32 %0, m0\n\ts_mov_b32 m0, %2\n\ts_nop 0\n\tglobal_load_lds_dwordx4 %1, off\n\ts_mov_b32 m0, %0":"=&s"(keep):"v"(gsrc),"s"(lds_dst):"memory");}
__device__ __forceinline__ float max3f(float a,float b,float c){float r;asm("v_max3_f32 %0, %1, %2, %3":"=v"(r):"v"(a),"v"(b),"v"(c));return r;}
__device__ __forceinline__ float max2f(float a,float b){float r;asm("v_max_f32_e32 %0, %1, %2":"=v"(r):"v"(a),"v"(b));return r;}
__device__ __forceinline__ float fadd_s(float a,float b){float r;asm("v_add_f32_e32 %0, %1, %2":"=v"(r):"v"(a),"v"(b));return r;}
__device__ __forceinline__ float fsub_s(float a,float b){float r;asm("v_sub_f32_e32 %0, %1, %2":"=v"(r):"v"(a),"v"(b));return r;}
typedef float f32x2_t __attribute__((ext_vector_type(2))); typedef __bf16 bf16x2_t __attribute__((ext_vector_type(2)));
__device__ __forceinline__ unsigned cvtpk_s(float lo,float hi){f32x2_t v={lo,hi};bf16x2_t b=__builtin_convertvector(v,bf16x2_t);return __builtin_bit_cast(unsigned,b);}
#define WAIT_BAR(N) asm volatile("s_waitcnt vmcnt(" #N ") lgkmcnt(0)\n\ts_barrier":::"memory")

__device__ __forceinline__ void qkt(f32x16&p0,f32x16&p1,const char*Kslot,const bf16x8*qr,const f32x16&negm,int r32,int hi){
  const char*kb=Kslot+hi*1024+r32*16;
  #pragma unroll
  for(int d0=0;d0<4;++d0){
    const bf16x8 b0=*reinterpret_cast<const bf16x8*>(kb+d0*2048);
    const bf16x8 b1=*reinterpret_cast<const bf16x8*>(kb+d0*2048+512);
    if(d0==0){p0=__builtin_amdgcn_mfma_f32_32x32x16_bf16(b0,qr[0],negm,0,0,0);p1=__builtin_amdgcn_mfma_f32_32x32x16_bf16(b1,qr[0],negm,0,0,0);}
    else{p0=__builtin_amdgcn_mfma_f32_32x32x16_bf16(b0,qr[d0],p0,0,0,0);p1=__builtin_amdgcn_mfma_f32_32x32x16_bf16(b1,qr[d0],p1,0,0,0);}}
}
typedef __attribute__((address_space(3))) const char* lds_cptr;
typedef short v4i16_t __attribute__((ext_vector_type(4)));
__device__ __forceinline__ void kload8(bf16x8*kf,lds_cptr kp){
  kf[0]=*(const __attribute__((address_space(3))) bf16x8*)(kp);      kf[1]=*(const __attribute__((address_space(3))) bf16x8*)(kp+512);
  kf[2]=*(const __attribute__((address_space(3))) bf16x8*)(kp+2048); kf[3]=*(const __attribute__((address_space(3))) bf16x8*)(kp+2560);
  kf[4]=*(const __attribute__((address_space(3))) bf16x8*)(kp+4096); kf[5]=*(const __attribute__((address_space(3))) bf16x8*)(kp+4608);
  kf[6]=*(const __attribute__((address_space(3))) bf16x8*)(kp+6144); kf[7]=*(const __attribute__((address_space(3))) bf16x8*)(kp+6656);
}
__device__ __forceinline__ void kload2(bf16x8*kf,lds_cptr kp,int j){ kf[2*j]=*(const __attribute__((address_space(3))) bf16x8*)(kp+j*2048); kf[2*j+1]=*(const __attribute__((address_space(3))) bf16x8*)(kp+j*2048+512); }
__device__ __forceinline__ s16x4 vtr(lds_cptr p){ return __builtin_bit_cast(s16x4,__builtin_amdgcn_ds_read_tr16_b64_v4i16((__attribute__((address_space(3))) v4i16_t*)p)); }
__device__ __forceinline__ float rowmax(const f32x16&p0,const f32x16&p1){
  float a=max3f(p0[0],p0[1],p1[0]),b=max3f(p0[2],p0[3],p1[1]);a=max3f(a,p1[2],p1[3]);
  #pragma unroll
  for(int r=4;r<16;r+=4){a=max3f(a,p0[r],p0[r+1]);b=max3f(b,p0[r+2],p0[r+3]);a=max3f(a,p1[r],p1[r+1]);b=max3f(b,p1[r+2],p1[r+3]);}
  const float m=max2f(a,b);
  auto rr=__builtin_amdgcn_permlane32_swap(__float_as_uint(m),__float_as_uint(m),false,false);
  return max2f(__uint_as_float(rr[0]),__uint_as_float(rr[1]));
}
__device__ __forceinline__ void pv(f32x16*o,int vb,bf16x8 pa0,bf16x8 pa1,bf16x8 pa2,bf16x8 pa3){
  #pragma unroll
  for(int d0=0;d0<2;++d0){s16x4 lo[4],hi[4];
    #pragma unroll
    for(int ks=0;ks<4;++ks){
      asm volatile("ds_read_b64_tr_b16 %0,%1 offset:%c2":"=&v"(lo[ks]):"v"(vb),"i"(d0*4096+ks*1024):"memory");
      asm volatile("ds_read_b64_tr_b16 %0,%1 offset:%c2":"=&v"(hi[ks]):"v"(vb),"i"(d0*4096+ks*1024+512):"memory");}
    asm volatile("s_waitcnt lgkmcnt(0)":::"memory");SBAR();
    #define PK(k) (bf16x8){lo[k][0],lo[k][1],lo[k][2],lo[k][3],hi[k][0],hi[k][1],hi[k][2],hi[k][3]}
    o[d0]=__builtin_amdgcn_mfma_f32_32x32x16_bf16(pa0,PK(0),o[d0],0,0,0);
    o[d0]=__builtin_amdgcn_mfma_f32_32x32x16_bf16(pa1,PK(1),o[d0],0,0,0);
    o[d0]=__builtin_amdgcn_mfma_f32_32x32x16_bf16(pa2,PK(2),o[d0],0,0,0);
    o[d0]=__builtin_amdgcn_mfma_f32_32x32x16_bf16(pa3,PK(3),o[d0],0,0,0);
    #undef PK
  }
}

#ifndef ATTN_STORE16
#define ATTN_STORE16(p,v) (*(u32x4*)(p)=(v))
#endif
template<int THRL,bool NOMAX> __device__ __forceinline__ void attn_unit(int b,int h,int qb,const bf16*Q,const bf16*__restrict__ K,const bf16*__restrict__ V,bf16*O,char*shm,const float*qgain,const float*ropef){
  int tid_l=threadIdx.x; asm volatile("":"+v"(tid_l)); const int tid=tid_l,lane=tid&63,r32=lane&31,hi=lane>>5; const int wid=__builtin_amdgcn_readfirstlane(tid>>6);
  const long rowbase=(long)b*SEQ; const int q0=qb*QB;
  const bf16*Qw=Q+(rowbase+q0+wid*QBLK)*QP+h*D;
  const bf16*Kh=K+rowbase*KP+(h>>2)*D,*Vh=V+rowbase*KP+(h>>2)*D;
  const unsigned lds0=(unsigned)(uintptr_t)shm;
  float*wsf=(float*)(shm+LDS_WS)+wid*64;
  const bf16*ksrc=Kh+(long)lane*KP+wid*8;
  const bf16*vsrc=Vh+(long)(16*(wid&3)+(lane>>2))*KP+(wid>>2)*32+(lane&3)*8;
  const unsigned kdst=lds0+LDS_K+wid*1024, vdst=lds0+LDS_V+wid*1024;
  #define DMA_K(t,slot) glds16(ksrc+(long)(t)*KVBLK*KP,(unsigned)__builtin_amdgcn_readfirstlane(kdst+(slot)))
  #define DMA_V(t,slot) glds16(vsrc+(long)(t)*KVBLK*KP,(unsigned)__builtin_amdgcn_readfirstlane(vdst+(slot)))
  const int vb0=(int)(lds0+LDS_V)+((lane>>4)&1)*32+(lane&3)*8+(4*hi+((lane&15)>>2))*64;
  const char*Kbase=shm+LDS_K; bf16x8 kf[8];
  const lds_cptr shm3=(lds_cptr)shm; const lds_cptr kp0=shm3+LDS_K+hi*1024+r32*16; const lds_cptr vp0=shm3+LDS_V+((lane>>4)&1)*32+(lane&3)*8+(4*hi+((lane&15)>>2))*64;
  const int NT=SEQ/KVBLK;
  DMA_K(0,0);DMA_V(0,0);DMA_K(1,SLOTB);
  bf16x8 qr[4];
  #pragma unroll
  for(int d0=0;d0<4;++d0)qr[d0]=*reinterpret_cast<const bf16x8*>(&Qw[(long)r32*QP+d0*16+hi*8]);
  { float ssq=0.f;
    #pragma unroll
    for(int d0=0;d0<4;++d0){
      #pragma unroll
      for(int i=0;i<8;++i){const float v=__uint_as_float((unsigned)(unsigned short)qr[d0][i]<<16);ssq+=v*v;}}
    ssq+=__shfl_xor(ssq,32);
    const float rs=__builtin_amdgcn_rsqf(ssq*(1.0f/64.0f)+1e-6f)*C2;
    const int spos=q0+wid*QBLK+r32;
    #pragma unroll
    for(int d0=0;d0<4;++d0){
      const float*gp=qgain+16*d0+8*hi; const f32x4q g0=*reinterpret_cast<const f32x4q*>(gp),g1=*reinterpret_cast<const f32x4q*>(gp+4);
      const float*rp=ropef+2*(((d0<2)?((spos>>6)*16):((128+(spos&63))*16))+((8*d0)&15)+4*hi);
      const f32x4q c0=*reinterpret_cast<const f32x4q*>(rp),c1=*reinterpret_cast<const f32x4q*>(rp+4);
      float y[8];
      #pragma unroll
      for(int i=0;i<8;++i)y[i]=__uint_as_float((unsigned)(unsigned short)qr[d0][i]<<16)*rs*(i<4?g0[i]:g1[i-4]);
      u32x4 w;
      w.x=cvtpk_s(y[0]*c0[0]-y[1]*c0[1],y[0]*c0[1]+y[1]*c0[0]); w.y=cvtpk_s(y[2]*c0[2]-y[3]*c0[3],y[2]*c0[3]+y[3]*c0[2]);
      w.z=cvtpk_s(y[4]*c1[0]-y[5]*c1[1],y[4]*c1[1]+y[5]*c1[0]); w.w=cvtpk_s(y[6]*c1[2]-y[7]*c1[3],y[6]*c1[3]+y[7]*c1[2]);
      qr[d0]=__builtin_bit_cast(bf16x8,w);}
  }
  float mhat=0.f,l_reg=0.f;f32x16 o[2];o[0]=f32x16{};o[1]=f32x16{};f32x16 negm=f32x16{};asm volatile("":"+v"(negm));
  const int qrel=wid*QBLK+r32;
  #define CMASK(P0,P1,t) do{}while(0)
  bool resc=false;
  #define START(P0,P1) do{ resc=false; if constexpr(!NOMAX) { const float rm=rowmax(P0,P1); const float dl=rm; mhat=fadd_s(mhat,dl); \
      _Pragma("unroll") for(int r=0;r<16;++r){P0[r]=fsub_s(P0[r],dl);P1[r]=fsub_s(P1[r],dl);} \
      _Pragma("unroll") for(int r=0;r<16;++r)negm[r]=-mhat; asm volatile("":"+v"(negm)); } \
    _Pragma("unroll") for(int r=0;r<16;++r)P0[r]=__builtin_amdgcn_exp2f(P0[r]); }while(0)
  #define RESC() do{ if(resc){ asm volatile("s_waitcnt lgkmcnt(0)":::"memory"); \
      _Pragma("unroll") for(int d_=0;d_<2;++d_) _Pragma("unroll") for(int r=0;r<16;++r)o[d_][r]*=wsf[crow(r,hi)]; } }while(0)
  f32x16 pA0,pA1,pB0,pB1;
  int sl_prev=0,sl_cur=0,sl_next=SLOTB;
  #define ROT() do{sl_prev=sl_cur;sl_cur=sl_next;sl_next=(sl_next==(NSLOT-1)*SLOTB)?0:sl_next+SLOTB;}while(0)
  DMA_K(2,2*SLOTB);
  WAIT_BAR(3);
  qkt(pA0,pA1,Kbase,qr,negm,r32,hi);asm volatile("s_nop 15\n\ts_nop 7":"+v"(pA0),"+v"(pA1));CMASK(pA0,pA1,0);
  START(pA0,pA1);
  _Pragma("unroll") for(int r=0;r<16;++r)pA1[r]=__builtin_amdgcn_exp2f(pA1[r]);
  WAIT_BAR(0);
  DMA_K(3,0);DMA_V(1,SLOTB);
  ROT();
  kload8(kf,kp0+sl_cur);
  WAIT_BAR(2);
  s16x4 vlo[8],vhi[8]; u32x4 pw0,pw1,pw2,pw3;
  #define PKW(P,B) cvtpk_s(P[B],P[B+1])
  #define PAF(k) __builtin_bit_cast(bf16x8,pw##k)
  #define VFR(i) (bf16x8){vlo[i][0],vlo[i][1],vlo[i][2],vlo[i][3],vhi[i][0],vhi[i][1],vhi[i][2],vhi[i][3]}
  #define PIN(x) asm volatile("":"+v"(x))
  #define MX3(a,b,c) __builtin_fmaxf(__builtin_fmaxf((a),(b)),(c))
  #define GAPA(MF,A0,A1,A2,A3,W0,W1,PW) do{ MF; sacc+=A0; sacc+=A1; sacc+=A2; sacc+=A3; PIN(sacc); W0; W1; PIN(PW); SBAR(); }while(0)
  #define EX(v) __builtin_amdgcn_exp2f(v)
  #define GAPB(MF,X,B) do{ MF; X[B]=EX(X[B]); X[B+1]=EX(X[B+1]); X[B+2]=EX(X[B+2]); X[B+3]=EX(X[B+3]); PIN(X); SBAR(); }while(0)
  #define VRD(i) do{ vlo[i]=vtr(vp_+(((i)>>2)*4096+((i)&3)*1024)); vhi[i]=vtr(vp_+(((i)>>2)*4096+((i)&3)*1024+512)); }while(0)
  #define KRD(G,j) do{ if(G){ kload2(kf,kp0+sl_next,j); SBAR(); } }while(0)
  #define STEP(C0,C1,P0,P1,t,GK,GV,GL) do{ SBAR(); \
    const lds_cptr vp_=vp0+sl_prev; \
    VRD(0); SBAR(); float sacc=(P0[0]+P0[1]); \
    GAPA(C0=__builtin_amdgcn_mfma_f32_32x32x16_bf16(kf[0],qr[0],negm,0,0,0), P0[2],P0[3],P0[4],P0[5],     pw0[0]=PKW(P0,0), pw0[1]=PKW(P0,2), pw0); \
    VRD(4); SBAR(); GAPA(C1=__builtin_amdgcn_mfma_f32_32x32x16_bf16(kf[1],qr[0],negm,0,0,0), P0[6],P0[7],P0[8],P0[9],     pw0[2]=PKW(P0,4), pw0[3]=PKW(P0,6), pw0); \
    VRD(1); SBAR(); GAPA(C0=__builtin_amdgcn_mfma_f32_32x32x16_bf16(kf[2],qr[1],C0,0,0,0),   P0[10],P0[11],P0[12],P0[13], pw1[0]=PKW(P0,8), pw1[1]=PKW(P0,10), pw1); \
    VRD(5); SBAR(); GAPA(C1=__builtin_amdgcn_mfma_f32_32x32x16_bf16(kf[3],qr[1],C1,0,0,0),   P0[14],P0[15],P1[0],P1[1],   pw1[2]=PKW(P0,12),pw1[3]=PKW(P0,14), pw1); \
    VRD(2); SBAR(); GAPA(C0=__builtin_amdgcn_mfma_f32_32x32x16_bf16(kf[4],qr[2],C0,0,0,0),   P1[2],P1[3],P1[4],P1[5],     pw2[0]=PKW(P1,0), pw2[1]=PKW(P1,2), pw2); \
    VRD(6); SBAR(); GAPA(C1=__builtin_amdgcn_mfma_f32_32x32x16_bf16(kf[5],qr[2],C1,0,0,0),   P1[6],P1[7],P1[8],P1[9],     pw2[2]=PKW(P1,4), pw2[3]=PKW(P1,6), pw2); \
    VRD(3); SBAR(); GAPA(C0=__builtin_amdgcn_mfma_f32_32x32x16_bf16(kf[6],qr[3],C0,0,0,0),   P1[10],P1[11],P1[12],P1[13], pw3[0]=PKW(P1,8), pw3[1]=PKW(P1,10), pw3); \
    VRD(7); SBAR(); GAPA(C1=__builtin_amdgcn_mfma_f32_32x32x16_bf16(kf[7],qr[3],C1,0,0,0),   P1[14],P1[15],0.f,0.f,       pw3[2]=PKW(P1,12),pw3[3]=PKW(P1,14), pw3); \
    l_reg+=sacc; \
    if(GK){DMA_K((t)+3,sl_cur);} if(GV){DMA_V((t)+1,sl_next);} \
    CMASK(C0,C1,t); \
    if constexpr(!NOMAX) { float a=MX3(C0[0],C0[1],C1[0]),b=MX3(C0[2],C0[3],C1[1]); a=MX3(a,C1[2],C1[3]); \
      _Pragma("unroll") for(int r=4;r<16;r+=4){a=MX3(a,C0[r],C0[r+1]);b=MX3(b,C0[r+2],C0[r+3]);a=MX3(a,C1[r],C1[r+1]);b=MX3(b,C1[r+2],C1[r+3]);} \
      float rm=__builtin_fmaxf(a,b); { auto rr=__builtin_amdgcn_permlane32_swap(__float_as_uint(rm),__float_as_uint(rm),false,false); rm=__builtin_fmaxf(__uint_as_float(rr[0]),__uint_as_float(rr[1])); } \
      resc=false; \
      if(__builtin_expect(__any(rm>(float)THRL),0)){ const float dl=__builtin_fmaxf(rm,0.f); mhat+=dl; \
        _Pragma("unroll") for(int r=0;r<16;++r){C0[r]-=dl;C1[r]-=dl;} \
        _Pragma("unroll") for(int r=0;r<16;++r)negm[r]=-mhat; asm volatile("":"+v"(negm)); \
        const float f=__builtin_amdgcn_exp2f(-dl); l_reg*=f; if(hi==0)wsf[r32]=f; resc=true; } } \
    SBAR(); \
    GAPB(o[0]=__builtin_amdgcn_mfma_f32_32x32x16_bf16(PAF(0),VFR(0),o[0],0,0,0), C0,0); \
    GAPB(o[1]=__builtin_amdgcn_mfma_f32_32x32x16_bf16(PAF(0),VFR(4),o[1],0,0,0), C0,4); \
    KRD(GL,0); GAPB(o[0]=__builtin_amdgcn_mfma_f32_32x32x16_bf16(PAF(1),VFR(1),o[0],0,0,0), C0,8); \
    KRD(GL,1); GAPB(o[1]=__builtin_amdgcn_mfma_f32_32x32x16_bf16(PAF(1),VFR(5),o[1],0,0,0), C0,12); \
    KRD(GL,2); GAPB(o[0]=__builtin_amdgcn_mfma_f32_32x32x16_bf16(PAF(2),VFR(2),o[0],0,0,0), C1,0); \
    KRD(GL,3); GAPB(o[1]=__builtin_amdgcn_mfma_f32_32x32x16_bf16(PAF(2),VFR(6),o[1],0,0,0), C1,4); \
    GAPB(o[0]=__builtin_amdgcn_mfma_f32_32x32x16_bf16(PAF(3),VFR(3),o[0],0,0,0), C1,8); \
    GAPB(o[1]=__builtin_amdgcn_mfma_f32_32x32x16_bf16(PAF(3),VFR(7),o[1],0,0,0), C1,12); \
    }while(0)
  if(__builtin_amdgcn_readfirstlane((int)threadIdx.x)>=256)__builtin_amdgcn_s_setprio(1);
  int t=1;
  #undef CMASK
  #define CMASK(P0,P1,t) do{}while(0)
  for(;t+5<NT;t+=2){
    STEP(pB0,pB1,pA0,pA1,t,true,true,true);     WAIT_BAR(2); RESC(); ROT();
    STEP(pA0,pA1,pB0,pB1,t+1,true,true,true);   WAIT_BAR(2); RESC(); ROT();
  }
  #undef CMASK
  #define CMASK(P0,P1,t) do{}while(0)
  #define ENDW(tt) do{ if((tt)+3<NT){WAIT_BAR(2);} else if((tt)+2<NT){WAIT_BAR(1);} else {WAIT_BAR(0);} }while(0)
  for(;t+1<NT;t+=2){
    STEP(pB0,pB1,pA0,pA1,t,(t+3<NT),(t+1<NT),(t+1<NT));       ENDW(t);   RESC(); ROT();
    STEP(pA0,pA1,pB0,pB1,t+1,(t+4<NT),(t+2<NT),(t+2<NT));     ENDW(t+1); RESC(); ROT();
  }
  STEP(pB0,pB1,pA0,pA1,NT-1,false,false,false); RESC();
  { float sacc=pB0[0]+pB0[1]; _Pragma("unroll") for(int r=2;r<16;++r)sacc+=pB0[r]; _Pragma("unroll") for(int r=0;r<16;++r)sacc+=pB1[r]; l_reg+=sacc;
    pw0=(u32x4){PKW(pB0,0),PKW(pB0,2),PKW(pB0,4),PKW(pB0,6)};pw1=(u32x4){PKW(pB0,8),PKW(pB0,10),PKW(pB0,12),PKW(pB0,14)};pw2=(u32x4){PKW(pB1,0),PKW(pB1,2),PKW(pB1,4),PKW(pB1,6)};pw3=(u32x4){PKW(pB1,8),PKW(pB1,10),PKW(pB1,12),PKW(pB1,14)};
    SBAR(); pv(o,vb0+sl_cur,PAF(0),PAF(1),PAF(2),PAF(3)); }
  #undef PKW
  #undef PAF
  #undef VFR
  #undef PIN
  #undef MX3
  #undef GAPA
  #undef GAPB
  #undef EX
  #undef VRD
  #undef KRD
  #undef STEP
  #undef ENDW
  __builtin_amdgcn_s_setprio(0);
  {auto rr=__builtin_amdgcn_permlane32_swap(__float_as_uint(l_reg),__float_as_uint(l_reg),false,false);l_reg=__uint_as_float(rr[0])+__uint_as_float(rr[1]);}
  if(hi==0)wsf[32+r32]=l_reg;asm volatile("s_waitcnt lgkmcnt(0)":::"memory");
  float rli[16];
  #pragma unroll
  for(int r=0;r<16;++r)rli[r]=__builtin_amdgcn_rcpf(wsf[32+crow(r,hi)]);
  bf16*Ow=O+(rowbase+q0+wid*QBLK)*OP+h*D;
  { bf16*stg=(bf16*)(shm+LDS_OST)+wid*2048;
    #pragma unroll
    for(int r=0;r<16;++r){const int orow=crow(r,hi);
      #pragma unroll
      for(int d0=0;d0<2;++d0)stg[orow*64+d0*32+r32]=__float2bfloat16(o[d0][r]*rli[r]);}
    asm volatile("s_waitcnt lgkmcnt(0)":::"memory");
    #pragma unroll
    for(int i=0;i<4;++i){const int row=i*8+(lane>>3),ch=lane&7; const u32x4 v=*(const u32x4*)(stg+row*64+ch*8); ATTN_STORE16(Ow+(long)row*OP+ch*8,v);} }
  asm volatile("s_waitcnt lgkmcnt(0)\n\ts_barrier":::"memory");
  #undef DMA_K
  #undef DMA_V
  #undef CMASK
  #undef START
  #undef RESC
  #undef ROT
}
constexpr int ATTN_LDS_BYTES=LDS_BYTES;
#undef SBAR
#undef WAIT_BAR
}
#define XB_TMO      128
#define XB_XCNT(j)  (256  + 64 * (j))
#define XB_XSUB(j)  (1280 + 64 * (j))
#define XB_XGEN(j)  (2304 + 64 * (j))
#define XB_TOP      3328
#define XB_TOPGEN   3392
#define XCD_BAR_WORDS 3456
#define XB_SPIN_CAP (1u << 18)

__device__ __forceinline__ unsigned xb_ld(unsigned* p)              { return __hip_atomic_load(p, __ATOMIC_RELAXED, __HIP_MEMORY_SCOPE_AGENT); }
__device__ __forceinline__ unsigned xb_add(unsigned* p, unsigned v) { return __hip_atomic_fetch_add(p, v, __ATOMIC_RELAXED, __HIP_MEMORY_SCOPE_AGENT); }
__device__ __forceinline__ unsigned xb_xcc_id() { return (unsigned)__builtin_amdgcn_s_getreg((3 << 11) | 20) & 0xFu; }
#define XB_SPIN(cond, bar) do { unsigned _sp = 0; while (cond) { __builtin_amdgcn_s_sleep(1); \
    if ((++_sp & 255u) == 0u) { if (xb_ld(&(bar)[XB_TMO])) break; if (_sp > XB_SPIN_CAP) { atomicAdd(&(bar)[XB_TMO], 1u); break; } } } } while (0)

struct XcdBarrier {
    unsigned* bar; unsigned x;
    volatile LAS unsigned* st;
};

__device__ __forceinline__ XcdBarrier xcd_barrier_post(unsigned* bar, volatile LAS unsigned* st) {
    XcdBarrier b; b.bar = bar; b.x = xb_xcc_id(); b.st = st;
    if (threadIdx.x == 0) (void)xb_add(&bar[XB_XCNT(b.x)], 1u);
    return b;
}
__device__ __forceinline__ void xcd_barrier_complete(unsigned* bar, unsigned x, unsigned& nloc, unsigned& nx) {
    const unsigned G = gridDim.x * gridDim.y * gridDim.z;
    unsigned sum, cnt, mine, sp = 0u;
    for (;;) {
        sum = 0u; cnt = 0u; mine = 0u;
#pragma unroll
        for (unsigned j = 0; j < 16; ++j) { const unsigned c = xb_ld(&bar[XB_XCNT(j)]); sum += c; cnt += (c > 0u) ? 1u : 0u; mine = (j == x) ? c : mine; }
        if (sum == G) break;
        __builtin_amdgcn_s_sleep(1);
        if ((++sp & 255u) == 0u) { if (xb_ld(&bar[XB_TMO])) break; if (sp > XB_SPIN_CAP) { atomicAdd(&bar[XB_TMO], 1u); break; } }
    }
    nloc = mine > 0u ? mine : 1u; nx = cnt > 0u ? cnt : 1u;
}

__device__ __forceinline__ void xcd_barrier(const XcdBarrier& b) {
    asm volatile("s_waitcnt vmcnt(0)" ::: "memory");
    __syncthreads();
    if (threadIdx.x == 0) {
        unsigned* bar = b.bar;
        __builtin_amdgcn_s_waitcnt(0);
        unsigned nloc = b.st[0], nx = b.st[1];
        if (nloc == 0u) { xcd_barrier_complete(bar, b.x, nloc, nx); b.st[0] = nloc; b.st[1] = nx; }
        const unsigned old = xb_add(&bar[XB_XSUB(b.x)], 1u);
        const unsigned gen = old / nloc;
        if (old + 1u == (gen + 1u) * nloc) {
            __builtin_amdgcn_fence(__ATOMIC_RELEASE, "agent");
            asm volatile("s_waitcnt vmcnt(0)" ::: "memory");
            const unsigned og = xb_add(&bar[XB_TOP], 1u);
            const unsigned tg = og / nx;
            if (og + 1u == (tg + 1u) * nx) xb_add(&bar[XB_TOPGEN], 1u);
            else XB_SPIN(xb_ld(&bar[XB_TOPGEN]) == tg, bar);
            __builtin_amdgcn_fence(__ATOMIC_ACQUIRE, "agent");
            xb_add(&bar[XB_XGEN(b.x)], 1u);
            asm volatile("s_waitcnt vmcnt(0)" ::: "memory");
        } else {
            XB_SPIN(xb_ld(&bar[XB_XGEN(b.x)]) == gen, bar);
            __builtin_amdgcn_fence(__ATOMIC_ACQUIRE, "agent");
            asm volatile("s_waitcnt vmcnt(0)" ::: "memory");
        }
    }
    __syncthreads();
}

namespace mk {
using pg8::bf16_t; using pg8::bf16x8; using pg8::f32x4; using pg8::u32x4;
typedef short s16x4 __attribute__((ext_vector_type(4)));
typedef float f32x16 __attribute__((ext_vector_type(16)));
typedef float f32x2 __attribute__((ext_vector_type(2)));
typedef unsigned u32x2 __attribute__((ext_vector_type(2)));

constexpr int NWAVES = 8, NTHR = 512;
constexpr int SEQ = 8192, NBATCH = 2, T = NBATCH * SEQ, DM = 1024, FF = 2816, NIN = 2320, NINP = 2560, NMEM = 256;
constexpr float EPS = 1e-6f, LOG2E = 1.4426950408889634f;
constexpr int OFF_Q = 0, OFF_K = 512, OFF_V = 640, OFF_CONV = 768, OFF_MQ = 1280, OFF_MK = 1536, OFF_MV = 1792, OFF_MO = 2048, OFF_MG = 2304;
constexpr int LDS_BYTES = 147456;
#ifndef PHM
#define PHM 1023
#endif
#ifndef GM
#define GM 0xffff
#endif

constexpr size_t MiB = 1u << 20, KiB = 1024;
constexpr size_t WS_W = 0, W_LAYER = 48 * MiB;
constexpr size_t O_W13A = 0, O_W2A = O_W13A + (size_t)5632 * 1024 * 2, O_WIN = O_W2A + (size_t)1024 * 2816 * 2, O_WOUT = O_WIN + (size_t)2560 * 1024 * 2, O_WQ = O_WOUT + 2 * MiB,
                 O_WKV = O_WQ + 2 * MiB, O_WO = O_WKV + 4 * MiB, O_W13B = O_WO + 2 * MiB, O_W2B = O_W13B + (size_t)5632 * 1024 * 2;
static_assert(O_W2B + (size_t)1024 * 2816 * 2 == W_LAYER, "weight map");
constexpr size_t WS_XN = 96 * MiB, WS_H = 128 * MiB, WS_Y = 216 * MiB, WS_GATES = 248 * MiB, WS_ROPE = 249 * MiB, WS_SS = 250 * MiB, WS_KX = 251 * MiB, WS_VXT = 253 * MiB, WS_END = 255 * MiB;
constexpr size_t ML_DC = WS_XN, ML_CST = WS_XN + 17 * MiB, ML_NST = WS_XN + 25 * MiB, ML_MST = WS_XN + 26 * MiB, ML_BEND = ML_MST + 64 * KiB, ML_MLOC = ML_MST + 128 * KiB;
constexpr size_t WS_CTL = 255 * MiB, CTL_BYTES = 16384, WS_TOTAL = WS_CTL + CTL_BYTES;
constexpr int MISC_OFF = LDS_BYTES - 64;
constexpr size_t WS_MEMN = WS_Y + 8 * MiB, WS_KVRAW = WS_H + 80 * MiB, WS_QX = WS_Y, WS_OX = WS_H;

__device__ const float INVF[16] = {1.0f, 0.5623413324356079f, 0.3162277638912201f, 0.17782793939113617f, 0.10000000149011612f, 0.05623413249850273f, 0.03162277489900589f, 0.017782794311642647f,
    0.009999999776482582f, 0.005623413249850273f, 0.003162277629598975f, 0.0017782794311642647f, 0.0010000000474974513f, 0.000562341301701963f, 0.0003162277571391314f, 0.00017782794020604342f};

struct Params { const float* in[26]; float* out; unsigned char* ws; };
typedef const __attribute__((address_space(4))) Params* KP;
enum { I_X = 0, I_MEM, I_F1N, I_F1W13, I_F1W2, I_MIXN, I_WIN, I_AQN, I_AKN, I_CW, I_CB, I_CLG, I_CLB, I_MGB, I_MON, I_WOUT, I_XN, I_MN, I_XWQ, I_XWKV, I_XQN, I_XKN, I_XWO, I_F2N, I_F2W13, I_F2W2 };

#define LDS_WAIT() asm volatile("s_waitcnt lgkmcnt(0)" ::: "memory")
#define LDS_BAR() asm volatile("s_waitcnt lgkmcnt(0)\n\ts_barrier" ::: "memory")
__device__ __forceinline__ float bf2f(unsigned short h) { return __uint_as_float((unsigned)h << 16); }
__device__ __forceinline__ unsigned pk2(float lo, float hi) { return pg8::cvt_pk_bf16(lo, hi); }
__device__ __forceinline__ float wave_sum(float v) {
#pragma unroll
    for (int o = 1; o < 64; o <<= 1) v += __shfl_xor(v, o);
    return v;
}
__device__ __forceinline__ float wave_max(float v) {
#pragma unroll
    for (int o = 1; o < 64; o <<= 1) v = fmaxf(v, __shfl_xor(v, o));
    return v;
}
__device__ __forceinline__ float wave_scan_add(float v, int lane) {
#pragma unroll
    for (int o = 1; o < 64; o <<= 1) { const float t = __shfl_up(v, o); if (lane >= o) v += t; }
    return v;
}
__device__ __forceinline__ float wave_scan_max(float v, int lane) {
#pragma unroll
    for (int o = 1; o < 64; o <<= 1) { const float t = __shfl_up(v, o); if (lane >= o) v = fmaxf(v, t); }
    return v;
}
__device__ __forceinline__ float logsigmoid_f(float x) { return fminf(x, 0.f) - log1pf(expf(-fabsf(x))); }
__device__ __forceinline__ float sigmoid_f(float x) { return 1.0f / (1.0f + __expf(-x)); }
__device__ __forceinline__ int crow(int r, int hi) { return (r & 3) + 8 * (r >> 2) + 4 * hi; }
__device__ __forceinline__ void unpack8(const bf16x8 v, float* f) {
#pragma unroll
    for (int i = 0; i < 8; ++i) f[i] = bf2f((unsigned short)v[i]);
}

__device__ __forceinline__ void transpose_item(const float* W, const float* gain, int K, int N, bf16_t* WT, int dst_row0, int k0, int n0, float* scr, int lane) {
    const int nn = n0 + (lane & 31);
    float wv[32];
    const float* wp = W + (size_t)(k0 + (lane >> 5)) * N + nn; const bool okn = nn < N;
#pragma unroll
    for (int i = 0; i < 32; ++i) wv[i] = okn ? wp[(size_t)(2 * i) * N] : 0.f;
    if (gain) {
#pragma unroll
        for (int i = 0; i < 32; ++i) wv[i] *= gain[k0 + 2 * i + (lane >> 5)]; }
#pragma unroll
    for (int i = 0; i < 32; ++i) scr[(2 * i + (lane >> 5)) * 33 + (lane & 31)] = wv[i];
    LDS_WAIT(); asm volatile("" ::: "memory");
    const int c = lane & 7;
#pragma unroll
    for (int j = 0; j < 4; ++j) { const int n = (lane >> 3) + 8 * j; const float* s = scr + (8 * c) * 33 + n;
        u32x4 o; o.x = pk2(s[0 * 33], s[1 * 33]); o.y = pk2(s[2 * 33], s[3 * 33]); o.z = pk2(s[4 * 33], s[5 * 33]); o.w = pk2(s[6 * 33], s[7 * 33]);
        *(u32x4*)(WT + (size_t)(dst_row0 + n) * K + k0 + 8 * c) = o; }
    LDS_WAIT(); asm volatile("" ::: "memory");
}
__device__ __forceinline__ void conv_weight(const float* W, const float* gain, int K, int N, int NP, bf16_t* WT, bool swz, int& cum, float* scr, int gw, int ngw, int lane) {
    const int nblk = NP / 32, nitems = (K / 64) * nblk;
    const int first = ((gw - (cum % ngw)) + ngw) % ngw;
    for (int it = first; it < nitems; it += ngw) {
        const int kb = it / nblk, nb = it % nblk, n0 = 32 * nb;
        int drow = n0;
        if (swz) drow = (n0 < FF) ? (n0 / 128) * 256 + (n0 % 128) : ((n0 - FF) / 128) * 256 + 128 + ((n0 - FF) % 128);
        transpose_item(W, gain, K, N, WT, drow, 64 * kb, n0, scr, lane);
    }
    cum += nitems;
}
__device__ __forceinline__ void norm_rows(const float* x, const float* gain, bf16_t* xn, int nrows, int vcu, int G) {
    int tid_l = threadIdx.x; asm volatile("" : "+v"(tid_l)); const int tid = tid_l, lane = tid & 63, wave = __builtin_amdgcn_readfirstlane(tid >> 6); (void)tid; (void)lane; (void)wave;
    const int gw = vcu * NWAVES + wave, ngw = G * NWAVES;
    f32x4 g[4];
#pragma unroll
    for (int j = 0; j < 4; ++j) g[j] = ((const f32x4*)gain)[lane + 64 * j];
    for (int m = gw; m < nrows; m += ngw) {
        const f32x4* xr = (const f32x4*)(x + (size_t)m * DM) + lane; f32x4 v[4]; float s = 0.f;
#pragma unroll
        for (int j = 0; j < 4; ++j) { v[j] = xr[64 * j]; s += (v[j].x * v[j].x + v[j].y * v[j].y) + (v[j].z * v[j].z + v[j].w * v[j].w); }
        const float rstd = rsqrtf(wave_sum(s) * (1.f / DM) + EPS);
        u32x2* o = (u32x2*)(xn + (size_t)m * DM) + lane;
#pragma unroll
        for (int j = 0; j < 4; ++j) { const f32x4 y = v[j] * rstd * g[j]; u32x2 w; w.x = pk2(y.x, y.y); w.y = pk2(y.z, y.w); o[64 * j] = w; }
    }
}
constexpr int W_ITEMS_LAYER = 12288;
__device__ __forceinline__ void convert_item(KP P, int gi, float* scr, int lane) {
    const int l = gi / W_ITEMS_LAYER, r = gi % W_ITEMS_LAYER; unsigned char* wb = P->ws + WS_W + (size_t)l * W_LAYER;
    int K = DM, N = DM, NP = DM, it = r; bool swz = false; const float* W; const float* gain = nullptr; bf16_t* WT;
    if (r < 2816)       { W = P->in[I_F1W13] + (size_t)l * DM * 2 * FF; gain = P->in[I_F1N] + l * DM; N = 2 * FF; NP = 2 * FF; WT = (bf16_t*)(wb + O_W13A); swz = true; it = r; }
    else if (r < 4224)  { W = P->in[I_F1W2] + (size_t)l * FF * DM; K = FF; WT = (bf16_t*)(wb + O_W2A); it = r - 2816; }
    else if (r < 5504)  { W = P->in[I_WIN] + (size_t)l * DM * NIN; gain = P->in[I_MIXN] + l * DM; N = NIN; NP = NINP; WT = (bf16_t*)(wb + O_WIN); it = r - 4224; }
    else if (r < 6016)  { W = P->in[I_WOUT] + (size_t)l * DM * DM; WT = (bf16_t*)(wb + O_WOUT); it = r - 5504; }
    else if (r < 6528)  { W = P->in[I_XWQ] + (size_t)l * DM * DM; gain = P->in[I_XN] + l * DM; WT = (bf16_t*)(wb + O_WQ); it = r - 6016; }
    else if (r < 7552)  { W = P->in[I_XWKV] + (size_t)l * DM * 2 * DM; N = 2 * DM; NP = 2 * DM; WT = (bf16_t*)(wb + O_WKV); it = r - 6528; }
    else if (r < 8064)  { W = P->in[I_XWO] + (size_t)l * DM * DM; WT = (bf16_t*)(wb + O_WO); it = r - 7552; }
    else if (r < 10880) { W = P->in[I_F2W13] + (size_t)l * DM * 2 * FF; gain = P->in[I_F2N] + l * DM; N = 2 * FF; NP = 2 * FF; WT = (bf16_t*)(wb + O_W13B); swz = true; it = r - 8064; }
    else                { W = P->in[I_F2W2] + (size_t)l * FF * DM; K = FF; WT = (bf16_t*)(wb + O_W2B); it = r - 10880; }
    const int nblk = NP / 32, kb = it / nblk, nb = it % nblk, n0 = 32 * nb;
    int drow = n0;
    if (swz) drow = (n0 < FF) ? (n0 / 128) * 256 + (n0 % 128) : ((n0 - FF) / 128) * 256 + 128 + ((n0 - FF) % 128);
    transpose_item(W, gain, K, N, WT, drow, 64 * kb, n0, scr, lane);
}
__device__ __forceinline__ void convert_items(KP P, unsigned char* lds, int first, int count, int widx, int nw) {
    asm volatile("" : "+s"(P)); int tid_l = threadIdx.x; asm volatile("" : "+v"(tid_l)); const int tid = tid_l, lane = tid & 63, wave = __builtin_amdgcn_readfirstlane(tid >> 6);
    float* scr = (float*)(lds + wave * 16384);
    for (int it = widx * 8 + wave; it < count; it += nw * 8) convert_item(P, first + it, scr, lane);
    __syncthreads();
}
__device__ __forceinline__ void xb_rows(const float* x, bf16_t* xb, float* SS, int nrows, int vcu, int G) {
    int tid_l = threadIdx.x; asm volatile("" : "+v"(tid_l)); const int tid = tid_l, lane = tid & 63, wave = __builtin_amdgcn_readfirstlane(tid >> 6);
    const int gw = vcu * NWAVES + wave, ngw = G * NWAVES;
    for (int m0 = gw * 2; m0 < nrows; m0 += ngw * 2) {
        f32x4 v[2][4];
#pragma unroll
        for (int q = 0; q < 2; ++q)
#pragma unroll
            for (int j = 0; j < 4; ++j) v[q][j] = ((const f32x4*)(x + (size_t)(m0 + q) * DM) + lane)[64 * j];
#pragma unroll
        for (int q = 0; q < 2; ++q) { const int m = m0 + q; float s = 0.f;
#pragma unroll
            for (int j = 0; j < 4; ++j) s += (v[q][j].x * v[q][j].x + v[q][j].y * v[q][j].y) + (v[q][j].z * v[q][j].z + v[q][j].w * v[q][j].w);
            s = wave_sum(s);
            u32x2* o = (u32x2*)(xb + (size_t)m * DM) + lane;
#pragma unroll
            for (int j = 0; j < 4; ++j) { u32x2 w; w.x = pk2(v[q][j].x, v[q][j].y); w.y = pk2(v[q][j].z, v[q][j].w); o[64 * j] = w; }
            if (lane < 16) SS[(size_t)m * 16 + lane] = lane == 0 ? s : 0.f; }
    }
}
__device__ __forceinline__ void rope_table(f32x2* tab, int gtid, int gthreads) {
    for (int e = gtid; e < 192 * 16; e += gthreads) {
        const int i = e >> 4, j = e & 15; const int idx = (i < 128) ? i : i - 128;
        const float ang = (float)idx * INVF[j];
        const double ad = (double)ang; const double nq = __builtin_rint(ad * 0.63661977236758134308); const float r = (float)(ad - nq * 1.57079632679489661923);
        const int q = ((int)nq) & 3; const float r2 = r * r;
        const float sn = r + r * r2 * (-1.0f / 6 + r2 * (1.0f / 120 + r2 * (-1.0f / 5040 + r2 * (1.0f / 362880))));
        const float cs = 1.0f + r2 * (-0.5f + r2 * (1.0f / 24 + r2 * (-1.0f / 720 + r2 * (1.0f / 40320 + r2 * (-1.0f / 3628800)))));
        float c, s_; if (q == 0) { s_ = sn; c = cs; } else if (q == 1) { s_ = cs; c = -sn; } else if (q == 2) { s_ = -sn; c = -cs; } else { s_ = -cs; c = sn; }
        tab[e] = (f32x2){c, s_};
    }
}
__device__ __forceinline__ void memprep(KP P, int vcu, int G) {
    asm volatile("" : "+s"(P)); int tid_l = threadIdx.x; asm volatile("" : "+v"(tid_l)); const int tid = tid_l, lane = tid & 63, wave = __builtin_amdgcn_readfirstlane(tid >> 6); (void)tid; (void)lane; (void)wave;
    const int gw = vcu * NWAVES + wave, ngw = G * NWAVES;
    const float* kvraw = (const float*)(P->ws + WS_KVRAW); bf16_t* KX = (bf16_t*)(P->ws + WS_KX); bf16_t* VXT = (bf16_t*)(P->ws + WS_VXT);
    for (int it = gw; it < 4096; it += ngw) {
        const int l = it >> 11, r = it & 2047, bm = r >> 2, h = r & 3, b = bm >> 8, m = bm & 255;
        const float* kv = kvraw + ((size_t)l * 512 + bm) * 2048;
        const f32x4 k = *(const f32x4*)(kv + h * 256 + lane * 4);
        const float rstd = rsqrtf(wave_sum((k.x * k.x + k.y * k.y) + (k.z * k.z + k.w * k.w)) * (1.f / 256) + EPS);
        const f32x4 kg = *(const f32x4*)(P->in[I_XKN] + l * 256 + lane * 4), qg = *(const f32x4*)(P->in[I_XQN] + l * 256 + lane * 4);
        const f32x4 y = k * rstd * kg * qg * (0.0625f * LOG2E);
        const size_t hb = ((size_t)(l * 2 + b) * 4 + h) * 65536;
        u32x2 w; w.x = pk2(y.x, y.y); w.y = pk2(y.z, y.w); *(u32x2*)(KX + hb + (size_t)m * 256 + lane * 4) = w;
        const f32x4 v = *(const f32x4*)(kv + 1024 + h * 256 + lane * 4);
#pragma unroll
        for (int i = 0; i < 4; ++i) VXT[hb + (size_t)(lane * 4 + i) * 256 + m] = (bf16_t)(pk2(v[i], 0.f) & 0xffffu);
    }
}
__device__ __forceinline__ void qkprep(KP P, int l, int vcu, int G) {
    asm volatile("" : "+s"(P)); int tid_l = threadIdx.x; asm volatile("" : "+v"(tid_l)); const int tid = tid_l, lane = tid & 63, wave = __builtin_amdgcn_readfirstlane(tid >> 6); (void)tid; (void)lane; (void)wave;
    const int gw = vcu * NWAVES + wave, ngw = G * NWAVES;
    bf16_t* HM = (bf16_t*)(P->ws + WS_H); const f32x2* rope = (const f32x2*)(P->ws + WS_ROPE);
    const float* qn = P->in[I_AQN] + l * 64; const float* kn = P->in[I_AKN] + l * 64;
    const int j = lane & 31;
    const float qg0 = qn[2 * j], qg1 = qn[2 * j + 1], kg0 = kn[2 * j], kg1 = kn[2 * j + 1];
    for (int tok0 = gw * 4; tok0 < T; tok0 += ngw * 4) {
        unsigned wv[4][5]; f32x2 cs[4];
#pragma unroll
        for (int q = 0; q < 4; ++q) { const int tok = tok0 + q, s = tok & (SEQ - 1); const bf16_t* row = HM + (size_t)tok * NINP;
            cs[q] = rope[(j < 16) ? ((s >> 6) * 16 + j) : ((128 + (s & 63)) * 16 + (j - 16))];
#pragma unroll
            for (int hp = 4; hp < 5; ++hp) wv[q][hp] = *(const unsigned*)(row + (hp * 2 + (lane >> 5)) * 64 + 2 * j); }
#pragma unroll
        for (int q = 0; q < 4; ++q) { bf16_t* row = HM + (size_t)(tok0 + q) * NINP;
#pragma unroll
            for (int hp = 4; hp < 5; ++hp) {
                const int head = hp * 2 + (lane >> 5); unsigned* p = (unsigned*)(row + head * 64 + 2 * j);
                const unsigned w = wv[q][hp]; const float x0 = __uint_as_float(w << 16), x1 = __uint_as_float(w & 0xffff0000u);
                float ss = x0 * x0 + x1 * x1;
#pragma unroll
                for (int o = 1; o < 32; o <<= 1) ss += __shfl_xor(ss, o);
                const float rstd = rsqrtf(ss * (1.f / 64) + EPS);
                const bool isq = head < 8;
                const float y0 = x0 * rstd * (isq ? qg0 : kg0), y1 = x1 * rstd * (isq ? qg1 : kg1);
                const float sc = isq ? attn_body::C2 : 1.0f;
                *p = pk2((y0 * cs[q].x - y1 * cs[q].y) * sc, (y0 * cs[q].y + y1 * cs[q].x) * sc);
            } }
    }
}
__device__ __forceinline__ void conv_phase(KP P, int l, unsigned char* lds, int vcu, int G) {
    asm volatile("" : "+s"(P)); int tid_l = threadIdx.x; asm volatile("" : "+v"(tid_l)); const int tid = tid_l, lane = tid & 63, wave = __builtin_amdgcn_readfirstlane(tid >> 6); (void)tid; (void)lane; (void)wave;
    const bf16_t* HM = (const bf16_t*)(P->ws + WS_H); bf16_t* Y = (bf16_t*)(P->ws + WS_Y);
    float* U = (float*)lds; float* CO = (float*)(lds + 63488);
    const float* dw = P->in[I_CW] + l * 31 * 256; const int ch = tid & 255, half = tid >> 8;
    for (int it = vcu; it < T / 32; it += G) {
        const int tok0 = it * 32, s0 = tok0 & (SEQ - 1), tb = tok0 - s0;
        {   const int rg = tid >> 5, c8 = tid & 31;
#pragma unroll
            for (int p = 0; p < 4; ++p) { const int r = p * 16 + rg; if (r < 62) { const int s = s0 - 15 + r; float uo[8];
                if (s >= 0 && s < SEQ) { const bf16_t* src = HM + (size_t)(tb + s) * NINP + OFF_CONV + c8 * 8; float a[8], g[8]; unpack8(*(const bf16x8*)src, a); unpack8(*(const bf16x8*)(src + 256), g);
#pragma unroll
                    for (int i = 0; i < 8; ++i) uo[i] = a[i] * sigmoid_f(g[i]); }
                else {
#pragma unroll
                    for (int i = 0; i < 8; ++i) uo[i] = 0.f; }
                *(f32x4*)(U + r * 256 + c8 * 8) = (f32x4){uo[0], uo[1], uo[2], uo[3]}; *(f32x4*)(U + r * 256 + c8 * 8 + 4) = (f32x4){uo[4], uo[5], uo[6], uo[7]}; } }
        }
        LDS_BAR();
        {   float acc[16]; const float bias = P->in[I_CB][l * 256 + ch];
#pragma unroll
            for (int t = 0; t < 16; ++t) acc[t] = bias;
            const float* ub = U + (half * 16) * 256 + ch; float uw[46], wk[31];
#pragma unroll
            for (int k = 0; k < 31; ++k) wk[k] = dw[k * 256 + ch];
#pragma unroll
            for (int r = 0; r < 46; ++r) uw[r] = ub[r * 256];
#pragma unroll
            for (int k = 0; k < 31; ++k)
#pragma unroll
                for (int t = 0; t < 16; ++t) acc[t] += wk[k] * uw[t + k];
#pragma unroll
            for (int t = 0; t < 16; ++t) CO[(half * 16 + t) * 256 + ch] = acc[t];
        }
        LDS_BAR();
        {   const f32x4 lg = *(const f32x4*)(P->in[I_CLG] + l * 256 + lane * 4), lb = *(const f32x4*)(P->in[I_CLB] + l * 256 + lane * 4);
#pragma unroll
            for (int q = 0; q < 4; ++q) { const int t = wave * 4 + q; const f32x4 x = *(const f32x4*)(CO + t * 256 + lane * 4);
                const float mean = wave_sum((x.x + x.y) + (x.z + x.w)) * (1.f / 256); const f32x4 d = x - mean;
                const float var = wave_sum((d.x * d.x + d.y * d.y) + (d.z * d.z + d.w * d.w)) * (1.f / 256); const f32x4 un = d * rsqrtf(var + EPS) * lg + lb;
                u32x2 w; w.x = pk2(un.x * sigmoid_f(un.x), un.y * sigmoid_f(un.y)); w.y = pk2(un.z * sigmoid_f(un.z), un.w * sigmoid_f(un.w));
                *(u32x2*)(Y + (size_t)(tok0 + t) * DM + 512 + lane * 4) = w; }
        }
        LDS_BAR();
    }
}
struct GateRaw { float ia, ib, fa, fb; };
__device__ __forceinline__ GateRaw chunk_gates_load(KP P, int tok0, int dir, int h, int lane) {
    const float* G = (const float*)(P->ws + WS_GATES);
    const int ra = dir ? 127 - lane : lane, rb = dir ? 63 - lane : lane + 64;
    const float* ga = G + (size_t)(tok0 + ra) * 16 + dir * 8; const float* gbp = G + (size_t)(tok0 + rb) * 16 + dir * 8;
    GateRaw g; g.ia = ga[h]; g.ib = gbp[h]; g.fa = ga[4 + h]; g.fb = gbp[4 + h]; return g;
}
__device__ __forceinline__ void chunk_gates_calc(KP P, int l, const GateRaw& g, int dir, int h, int lane, float& gia, float& gib, float& ba, float& bb) {
    const float* gb = P->in[I_MGB] + l * 16 + dir * 8;
    gia = g.ia + gb[h]; gib = g.ib + gb[h];
    const float lfa = logsigmoid_f(g.fa + gb[4 + h]), lfb = logsigmoid_f(g.fb + gb[4 + h]);
    ba = wave_scan_add(lfa, lane); const float tot = __shfl(ba, 63); bb = wave_scan_add(lfb, lane) + tot;
}
__device__ __forceinline__ void chunk_gates(KP P, int l, int tok0, int dir, int h, int lane, float& gia, float& gib, float& ba, float& bb) {
    const GateRaw g = chunk_gates_load(P, tok0, dir, h, lane); chunk_gates_calc(P, l, g, dir, h, lane, gia, gib, ba, bb);
}
__device__ __forceinline__ void mlstm_local(KP P, int l, unsigned char* lds, int vcu, int G) {
    asm volatile("" : "+s"(P)); int tid_l = threadIdx.x; asm volatile("" : "+v"(tid_l)); const int tid = tid_l, lane = tid & 63, wave = __builtin_amdgcn_readfirstlane(tid >> 6); (void)tid; (void)lane; (void)wave;
    const bf16_t* HM = (const bf16_t*)(P->ws + WS_H); float* DC = (float*)(P->ws + ML_DC); float* BEND = (float*)(P->ws + ML_BEND); float* MLOC = (float*)(P->ws + ML_MLOC);
    float* Ks = (float*)lds; float* VW0 = (float*)(lds + 32768); float* VW1 = (float*)(lds + 65536); float* wrow = (float*)(lds + 98304);
    for (int it = vcu; it < 512; it += G) {
        const int b = it >> 8, h = (it >> 6) & 3, c = it & 63, tok0 = b * SEQ + c * 128;
        const int idx0 = ((b * 2 + 0) * 4 + h) * 64 + c, idx1 = ((b * 2 + 1) * 4 + h) * 64 + (63 - c);
        const int r = tid >> 2, q4 = tid & 3; const bf16_t* src = HM + (size_t)(tok0 + r) * NINP + h * 64 + q4 * 16;
        const bf16x8 k0v = *(const bf16x8*)(src + OFF_MK), k1v = *(const bf16x8*)(src + OFF_MK + 8), v0v = *(const bf16x8*)(src + OFF_MV), v1v = *(const bf16x8*)(src + OFF_MV + 8);
        bf16_t* kp = (bf16_t*)HM + (size_t)(tok0 + r) * NINP + OFF_K + (h & 1) * 64 + q4 * 16;
        bf16x8 ka = {0, 0, 0, 0, 0, 0, 0, 0}, kb = ka;
        if (h < 2) { ka = *(const bf16x8*)kp; kb = *(const bf16x8*)(kp + 8); }
        if (h < 2) {
            float kf[16]; unpack8(ka, kf); unpack8(kb, kf + 8); float ssk = 0.f;
#pragma unroll
            for (int i = 0; i < 16; ++i) ssk += kf[i] * kf[i];
            ssk += __shfl_xor(ssk, 1); ssk += __shfl_xor(ssk, 2);
            const float rsk = rsqrtf(ssk * (1.f / 64) + EPS);
            const int spos = c * 128 + r; const float* kn = P->in[I_AKN] + l * 64 + q4 * 16;
            const float* rp = (const float*)(P->ws + WS_ROPE) + 2 * (((q4 < 2) ? ((spos >> 6) * 16) : ((128 + (spos & 63)) * 16)) + ((8 * q4) & 15));
            unsigned wq[8];
#pragma unroll
            for (int p2 = 0; p2 < 8; ++p2) { const float y0 = kf[2 * p2] * rsk * kn[2 * p2], y1 = kf[2 * p2 + 1] * rsk * kn[2 * p2 + 1]; const float cc = rp[2 * p2], sn = rp[2 * p2 + 1];
                wq[p2] = pk2(y0 * cc - y1 * sn, y0 * sn + y1 * cc); }
            *(u32x4*)kp = (u32x4){wq[0], wq[1], wq[2], wq[3]}; *(u32x4*)(kp + 8) = (u32x4){wq[4], wq[5], wq[6], wq[7]};
        }
        if (wave < 2) {
            const int dir = wave; float gia, gib, ba, bb; chunk_gates(P, l, tok0, dir, h, lane, gia, gib, ba, bb);
            const float bend = __shfl(bb, 63); const float lwa = bend - ba + gia, lwb = bend - bb + gib; const float mloc = wave_max(fmaxf(lwa, lwb));
            wrow[dir * 128 + (dir ? 127 - lane : lane)] = expf(lwa - mloc) * 0.125f; wrow[dir * 128 + (dir ? 63 - lane : lane + 64)] = expf(lwb - mloc) * 0.125f;
            if (lane == 0) { BEND[dir ? idx1 : idx0] = bend; MLOC[dir ? idx1 : idx0] = mloc; }
        }
        LDS_BAR();
        {   const float w0 = wrow[r], w1 = wrow[128 + r];
#pragma unroll
            for (int hh = 0; hh < 2; ++hh) { float k[8], v[8]; unpack8(hh ? k1v : k0v, k); unpack8(hh ? v1v : v0v, v);
                const int o = r * 64 + q4 * 16 + hh * 8;
                *(f32x4*)(Ks + o) = (f32x4){k[0], k[1], k[2], k[3]}; *(f32x4*)(Ks + o + 4) = (f32x4){k[4], k[5], k[6], k[7]};
                *(f32x4*)(VW0 + o) = (f32x4){v[0] * w0, v[1] * w0, v[2] * w0, v[3] * w0}; *(f32x4*)(VW0 + o + 4) = (f32x4){v[4] * w0, v[5] * w0, v[6] * w0, v[7] * w0};
                *(f32x4*)(VW1 + o) = (f32x4){v[0] * w1, v[1] * w1, v[2] * w1, v[3] * w1}; *(f32x4*)(VW1 + o + 4) = (f32x4){v[4] * w1, v[5] * w1, v[6] * w1, v[7] * w1}; }
        }
        LDS_BAR();
        {   const int e0 = (tid >> 4) * 2, d0 = (tid & 15) * 4; const f32x4 z = {0.f, 0.f, 0.f, 0.f}; f32x4 a0 = z, a1 = z, b0 = z, b1 = z, an = z;
            float* dst0 = DC + (size_t)idx0 * 4160; float* dst1 = DC + (size_t)idx1 * 4160;
            if (wave < 2) {
                const float* wn = wrow + wave * 128;
#pragma unroll 4
                for (int rr = 0; rr < 128; ++rr) { const f32x2 v0 = *(const f32x2*)(VW0 + rr * 64 + e0), v1 = *(const f32x2*)(VW1 + rr * 64 + e0); const f32x4 k = *(const f32x4*)(Ks + rr * 64 + d0);
                    a0 += k * v0.x; a1 += k * v0.y; b0 += k * v1.x; b1 += k * v1.y; an += k * wn[rr]; }
                if ((tid & 63) < 16) *(f32x4*)((wave ? dst1 : dst0) + 4096 + d0) = an;
            } else {
#pragma unroll 4
                for (int rr = 0; rr < 128; ++rr) { const f32x2 v0 = *(const f32x2*)(VW0 + rr * 64 + e0), v1 = *(const f32x2*)(VW1 + rr * 64 + e0); const f32x4 k = *(const f32x4*)(Ks + rr * 64 + d0);
                    a0 += k * v0.x; a1 += k * v0.y; b0 += k * v1.x; b1 += k * v1.y; }
            }
            *(f32x4*)(dst0 + e0 * 64 + d0) = a0; *(f32x4*)(dst0 + (e0 + 1) * 64 + d0) = a1;
            *(f32x4*)(dst1 + e0 * 64 + d0) = b0; *(f32x4*)(dst1 + (e0 + 1) * 64 + d0) = b1;
        }
        LDS_BAR();
    }
}
__device__ __forceinline__ void mlstm_scan(KP P, int vcu, int G) {
    asm volatile("" : "+s"(P)); int tid_l = threadIdx.x; asm volatile("" : "+v"(tid_l)); const int tid = tid_l, lane = tid & 63, wave = __builtin_amdgcn_readfirstlane(tid >> 6); (void)tid; (void)lane; (void)wave;
    const float* DC = (const float*)(P->ws + ML_DC); const float* BEND = (const float*)(P->ws + ML_BEND); const float* MLOC = (const float*)(P->ws + ML_MLOC);
    bf16_t* CST = (bf16_t*)(P->ws + ML_CST); float* NST = (float*)(P->ws + ML_NST); float* MST = (float*)(P->ws + ML_MST);
    for (int it = vcu; it < 144; it += G) {
        const int chain = it / 9, elem = (it % 9) * 512 + tid;
        if (elem < 4160) {
            float C = 0.f, m = 0.f;
            const float* dcp = DC + (size_t)chain * 64 * 4160 + elem; const float* bep = BEND + chain * 64; const float* mlp = MLOC + chain * 64;
            float dcn[4], ben[4], mln[4];
#pragma unroll
            for (int j = 0; j < 4; ++j) { dcn[j] = dcp[(size_t)j * 4160]; ben[j] = bep[j]; mln[j] = mlp[j]; }
#pragma unroll 1
            for (int c0 = 0; c0 < 64; c0 += 4) {
                float dc[4], be[4], ml[4];
#pragma unroll
                for (int j = 0; j < 4; ++j) { dc[j] = dcn[j]; be[j] = ben[j]; ml[j] = mln[j]; }
                if (c0 + 4 < 64) {
#pragma unroll
                    for (int j = 0; j < 4; ++j) { dcn[j] = dcp[(size_t)(c0 + 4 + j) * 4160]; ben[j] = bep[c0 + 4 + j]; mln[j] = mlp[c0 + 4 + j]; } }
#pragma unroll
                for (int j = 0; j < 4; ++j) { const int base = chain * 64 + c0 + j;
                    if (elem < 4096) CST[(size_t)base * 4096 + elem] = (bf16_t)(pk2(C, 0.f) & 0xffffu); else NST[base * 64 + elem - 4096] = C;
                    if (elem == 0) MST[base] = m;
                    const float mn = fmaxf(be[j] + m, ml[j]);
                    C = __expf(be[j] + m - mn) * C + __expf(ml[j] - mn) * dc[j]; m = mn; }
            }
        }
    }
}
__device__ __forceinline__ void mlstm_out(KP P, int l, unsigned char* lds, int vcu, int G) {
    asm volatile("" : "+s"(P)); int tid_l = threadIdx.x; asm volatile("" : "+v"(tid_l)); const int tid = tid_l, lane = tid & 63, wave = __builtin_amdgcn_readfirstlane(tid >> 6); (void)tid; (void)lane; (void)wave;
    const bf16_t* HM = (const bf16_t*)(P->ws + WS_H); bf16_t* Y = (bf16_t*)(P->ws + WS_Y);
    const bf16_t* CST = (const bf16_t*)(P->ws + ML_CST); const float* NST = (const float*)(P->ws + ML_NST); const float* MST = (const float*)(P->ws + ML_MST);
    bf16_t* QS = (bf16_t*)lds; bf16_t* KS = (bf16_t*)(lds + 18432); bf16_t* VT = (bf16_t*)(lds + 36864); bf16_t* CS = (bf16_t*)(lds + 54272);
    float* NS = (float*)(lds + 72704); float* BETA = (float*)(lds + 73216); float* MU = (float*)(lds + 74240); float* EMT = (float*)(lds + 75264); float* INTER = (float*)(lds + 76288);
    float* RDEN = (float*)(lds + 77312); float* HB = (float*)(lds + 78336);
    const int r32 = lane & 31, hi = lane >> 5;
    for (int it = vcu; it < 512; it += G) {
        const int b = it >> 8, h = (it >> 6) & 3, c = it & 63, tok0 = b * SEQ + c * 128;
        const int sb0 = ((b * 2 + 0) * 4 + h) * 64 + c, sb1 = ((b * 2 + 1) * 4 + h) * 64 + (63 - c);
        const bf16_t* hsrc = HM + (size_t)(tok0 + (tid >> 2)) * NINP + h * 64 + (tid & 3) * 16;
        const bf16x8 ho0 = *(const bf16x8*)(hsrc + OFF_MO), ho1 = *(const bf16x8*)(hsrc + OFF_MO + 8);
        GateRaw graw = {0.f, 0.f, 0.f, 0.f}; float mprev_l = 0.f;
        if (wave < 2) { graw = chunk_gates_load(P, tok0, wave, h, lane); mprev_l = MST[wave ? sb1 : sb0]; }
        {   const int r = tid >> 2, q4 = tid & 3; const bf16_t* src = hsrc;
            const bf16x8 q0 = *(const bf16x8*)(src + OFF_MQ), q1 = *(const bf16x8*)(src + OFF_MQ + 8), k0 = *(const bf16x8*)(src + OFF_MK), k1 = *(const bf16x8*)(src + OFF_MK + 8);
            const bf16x8 v0 = *(const bf16x8*)(src + OFF_MV), v1 = *(const bf16x8*)(src + OFF_MV + 8);
            *(bf16x8*)(QS + r * 72 + q4 * 16) = q0; *(bf16x8*)(QS + r * 72 + q4 * 16 + 8) = q1;
            *(bf16x8*)(KS + r * 72 + q4 * 16) = k0; *(bf16x8*)(KS + r * 72 + q4 * 16 + 8) = k1;
#pragma unroll
            for (int i = 0; i < 8; ++i) { VT[(q4 * 16 + i) * 136 + r] = (bf16_t)v0[i]; VT[(q4 * 16 + 8 + i) * 136 + r] = (bf16_t)v1[i]; }
            const int e = tid >> 3, dq = tid & 7;
            *(bf16x8*)(CS + e * 72 + dq * 8) = *(const bf16x8*)(CST + (size_t)sb0 * 4096 + e * 64 + dq * 8);
            *(bf16x8*)(CS + 4608 + e * 72 + dq * 8) = *(const bf16x8*)(CST + (size_t)sb1 * 4096 + e * 64 + dq * 8);
            if (tid < 128) NS[tid] = NST[(tid < 64 ? sb0 : sb1) * 64 + (tid & 63)];
        }
        if (wave < 2) {
            const int dir = wave; float gia, gib, ba, bb; chunk_gates_calc(P, l, graw, dir, h, lane, gia, gib, ba, bb);
            const float mprev = mprev_l;
            const float bta = gia - ba, btb = gib - bb;
            const float pa = wave_scan_max(bta, lane); const float pb = fmaxf(wave_scan_max(btb, lane), __shfl(pa, 63));
            const float mua = fmaxf(pa, mprev), mub = fmaxf(pb, mprev);
            const int ra = dir ? 127 - lane : lane, rb = dir ? 63 - lane : lane + 64;
            BETA[dir * 128 + ra] = bta; BETA[dir * 128 + rb] = btb; MU[dir * 128 + ra] = mua; MU[dir * 128 + rb] = mub;
            EMT[dir * 128 + ra] = expf(-(ba + mua)); EMT[dir * 128 + rb] = expf(-(bb + mub));
            INTER[dir * 128 + ra] = expf(mprev - mua); INTER[dir * 128 + rb] = expf(mprev - mub);
        }
        LDS_BAR();
        {   const int dir = wave >> 2, rb = wave & 3, t = 32 * rb + r32;
            bf16x8 qr[4];
#pragma unroll
            for (int ks = 0; ks < 4; ++ks) qr[ks] = *(const bf16x8*)(QS + t * 72 + 16 * ks + 8 * hi);
            const float mu_t = MU[dir * 128 + t], inter_t = INTER[dir * 128 + t];
            f32x16 o0 = {}, o1 = {}; float rowsum = 0.f;
            for (int sb = 0; sb < 4; ++sb) {
                if (dir == 0 ? (sb > rb) : (sb < rb)) continue;
                f32x16 p = {};
#pragma unroll
                for (int ks = 0; ks < 4; ++ks) { const bf16x8 kf = *(const bf16x8*)(KS + (32 * sb + r32) * 72 + 16 * ks + 8 * hi); p = __builtin_amdgcn_mfma_f32_32x32x16_bf16(kf, qr[ks], p, 0, 0, 0); }
#pragma unroll
                for (int rq = 0; rq < 4; ++rq) { const f32x4 bt = *(const f32x4*)(BETA + dir * 128 + 32 * sb + 8 * rq + 4 * hi);
#pragma unroll
                    for (int i = 0; i < 4; ++i) { const int s = 32 * sb + 8 * rq + 4 * hi + i; const bool valid = dir == 0 ? (s <= t) : (s >= t);
                        const float w = valid ? __expf(bt[i] - mu_t) * 0.125f : 0.f; const float v = p[rq * 4 + i] * w; p[rq * 4 + i] = v; rowsum += v; } }
                u32x4 pw0, pw1;
                pw0.x = pk2(p[0], p[1]); pw0.y = pk2(p[2], p[3]); pw0.z = pk2(p[4], p[5]); pw0.w = pk2(p[6], p[7]);
                pw1.x = pk2(p[8], p[9]); pw1.y = pk2(p[10], p[11]); pw1.z = pk2(p[12], p[13]); pw1.w = pk2(p[14], p[15]);
#pragma unroll
                for (int kb = 0; kb < 2; ++kb) { const bf16x8 pa = __builtin_bit_cast(bf16x8, kb ? pw1 : pw0);
#pragma unroll
                    for (int eb = 0; eb < 2; ++eb) { const bf16_t* vp = VT + (32 * eb + r32) * 136 + 32 * sb + 16 * kb + 4 * hi;
                        const s16x4 lo = *(const s16x4*)vp, hi4 = *(const s16x4*)(vp + 8);
                        const bf16x8 vf = {lo[0], lo[1], lo[2], lo[3], hi4[0], hi4[1], hi4[2], hi4[3]};
                        if (eb == 0) o0 = __builtin_amdgcn_mfma_f32_32x32x16_bf16(pa, vf, o0, 0, 0, 0); else o1 = __builtin_amdgcn_mfma_f32_32x32x16_bf16(pa, vf, o1, 0, 0, 0); } }
            }
            float nq = 0.f;
#pragma unroll
            for (int ks = 0; ks < 4; ++ks) { float qf[8]; unpack8(qr[ks], qf); const float* np = NS + dir * 64 + 16 * ks + 8 * hi;
#pragma unroll
                for (int i = 0; i < 8; ++i) nq += qf[i] * np[i];
                u32x4 qw; qw.x = pk2(qf[0] * inter_t, qf[1] * inter_t); qw.y = pk2(qf[2] * inter_t, qf[3] * inter_t); qw.z = pk2(qf[4] * inter_t, qf[5] * inter_t); qw.w = pk2(qf[6] * inter_t, qf[7] * inter_t);
                const bf16x8 qs = __builtin_bit_cast(bf16x8, qw);
                const bf16x8 c0 = *(const bf16x8*)(CS + dir * 4608 + r32 * 72 + 16 * ks + 8 * hi), c1 = *(const bf16x8*)(CS + dir * 4608 + (32 + r32) * 72 + 16 * ks + 8 * hi);
                o0 = __builtin_amdgcn_mfma_f32_32x32x16_bf16(qs, c0, o0, 0, 0, 0); o1 = __builtin_amdgcn_mfma_f32_32x32x16_bf16(qs, c1, o1, 0, 0, 0); }
            float den = rowsum + inter_t * nq; den += __shfl_xor(den, 32);
            const float rden = 1.0f / fmaxf(fabsf(den), EMT[dir * 128 + t]);
            if (hi == 0) RDEN[wave * 32 + r32] = rden;
            LDS_WAIT(); asm volatile("" ::: "memory");
#pragma unroll
            for (int rq = 0; rq < 4; ++rq) { const f32x4 rd = *(const f32x4*)(RDEN + wave * 32 + 8 * rq + 4 * hi);
#pragma unroll
                for (int i = 0; i < 4; ++i) { float* hp = HB + (dir * 128 + 32 * rb + 8 * rq + 4 * hi + i) * 65; hp[r32] = o0[rq * 4 + i] * rd[i]; hp[32 + r32] = o1[rq * 4 + i] * rd[i]; } }
        }
        LDS_BAR();
        {   const int r = tid >> 2, q4 = tid & 3; float hv[16]; float ss = 0.f;
#pragma unroll
            for (int i = 0; i < 16; ++i) { hv[i] = HB[r * 65 + q4 * 16 + i] + HB[(128 + r) * 65 + q4 * 16 + i]; ss += hv[i] * hv[i]; }
            ss += __shfl_xor(ss, 1); ss += __shfl_xor(ss, 2);
            const float rstd = rsqrtf(ss * (1.f / 64) + EPS);
            const float* gn = P->in[I_MON] + l * 256 + h * 64 + q4 * 16;
            float ho[16]; unpack8(ho0, ho); unpack8(ho1, ho + 8);
            u32x4 w0, w1; float ov[16];
#pragma unroll
            for (int i = 0; i < 16; ++i) ov[i] = hv[i] * rstd * gn[i] * sigmoid_f(ho[i]);
            w0.x = pk2(ov[0], ov[1]); w0.y = pk2(ov[2], ov[3]); w0.z = pk2(ov[4], ov[5]); w0.w = pk2(ov[6], ov[7]);
            w1.x = pk2(ov[8], ov[9]); w1.y = pk2(ov[10], ov[11]); w1.z = pk2(ov[12], ov[13]); w1.w = pk2(ov[14], ov[15]);
            bf16_t* yp = Y + (size_t)(tok0 + r) * DM + 768 + h * 64 + q4 * 16; *(u32x4*)yp = w0; *(u32x4*)(yp + 8) = w1;
        }
        LDS_BAR();
    }
}
__device__ __forceinline__ int xt_off(int row) { return ((row >> 5) * 16 + (row & 15)) * 1040 + ((row >> 4) & 1) * 512; }
__device__ __forceinline__ void xattn_phase(KP P, int l, unsigned char* lds, int vcu, int G, int fixed_u) {
    asm volatile("" : "+s"(P)); int tid_l = threadIdx.x; asm volatile("" : "+v"(tid_l)); const int tid = tid_l, lane = tid & 63, wave = __builtin_amdgcn_readfirstlane(tid >> 6);
    const bf16_t* QX = (const bf16_t*)(P->ws + WS_QX); bf16_t* OX = (bf16_t*)(P->ws + WS_OX);
    const bf16_t* KX = (const bf16_t*)(P->ws + WS_KX); const bf16_t* VXT = (const bf16_t*)(P->ws + WS_VXT);
    const unsigned lds0 = (unsigned)(uintptr_t)lds;
    const int r32 = lane & 31, hi = lane >> 5;
    const unsigned char* kfb = lds + xt_off(r32) + 16 * hi;
    const unsigned char* vfb = lds + xt_off(r32) + 8 * hi;
    for (int u = (fixed_u >= 0 ? fixed_u : vcu); u < 256; u += (fixed_u >= 0 ? 256 : G)) {
        const int b = u >> 7, h = (u >> 5) & 3, qb = u & 31; const int tokw = b * SEQ + qb * 256 + wave * 32;
        const bf16_t* qrow = QX + (size_t)(tokw + r32) * DM + h * 256 + 8 * hi;
        const size_t hb = ((size_t)(l * 2 + b) * 4 + h) * 65536;
        {   const bf16_t* src = KX + hb + (size_t)(wave * 32 + 16 * (lane >> 5)) * 256 + (lane & 31) * 8;
#pragma unroll
            for (int i = 0; i < 16; ++i) attn_body::glds16(src + i * 256, (unsigned)__builtin_amdgcn_readfirstlane(lds0 + (unsigned)(wave * 16 + i) * 1040u));
        }
        bf16x8 qa[4], qn[4]; float ss = 0.f;
#pragma unroll
        for (int j = 0; j < 4; ++j) { qa[j] = *(const bf16x8*)(qrow + 16 * j); qn[j] = *(const bf16x8*)(qrow + 64 + 16 * j); }
        asm volatile("s_waitcnt vmcnt(0)" ::: "memory"); __syncthreads();
        f32x16 p[8];
#pragma unroll
        for (int mb = 0; mb < 8; ++mb) p[mb] = (f32x16){};
#pragma unroll 1
        for (int g = 0; g < 4; ++g) {
#pragma unroll
            for (int j = 0; j < 4; ++j) { float qf[8]; unpack8(qa[j], qf);
#pragma unroll
                for (int i = 0; i < 8; ++i) ss += qf[i] * qf[i];
#pragma unroll
                for (int mb = 0; mb < 8; ++mb) { const bf16x8 kf = *(const bf16x8*)(kfb + 16 * 1040 * mb + 128 * g + 32 * j); p[mb] = __builtin_amdgcn_mfma_f32_32x32x16_bf16(kf, qa[j], p[mb], 0, 0, 0); }
                __builtin_amdgcn_sched_barrier(0); }
#pragma unroll
            for (int j = 0; j < 4; ++j) { qa[j] = qn[j]; if (g < 2) qn[j] = *(const bf16x8*)(qrow + 64 * (g + 2) + 16 * j); }
        }
        asm volatile("s_waitcnt lgkmcnt(0)" ::: "memory"); __syncthreads();
        {   const bf16_t* src = VXT + hb + (size_t)(wave * 32 + 16 * (lane >> 5)) * 256 + (lane & 31) * 8;
#pragma unroll
            for (int i = 0; i < 16; ++i) attn_body::glds16(src + i * 256, (unsigned)__builtin_amdgcn_readfirstlane(lds0 + (unsigned)(wave * 16 + i) * 1040u));
        }
        ss += __shfl_xor(ss, 32);
        const float rstd = rsqrtf(ss * (1.f / 256) + EPS);
        float mx = -INFINITY;
#pragma unroll
        for (int mb = 0; mb < 8; ++mb)
#pragma unroll
            for (int r = 0; r < 16; ++r) mx = fmaxf(mx, p[mb][r]);
        mx = fmaxf(mx, __shfl_xor(mx, 32)); mx *= rstd;
        float lsum = 0.f; u32x4 pw[8][2];
#pragma unroll
        for (int mb = 0; mb < 8; ++mb) {
#pragma unroll
            for (int r = 0; r < 16; ++r) { const float e = __builtin_amdgcn_exp2f(p[mb][r] * rstd - mx); p[mb][r] = e; lsum += e; }
            pw[mb][0].x = pk2(p[mb][0], p[mb][1]); pw[mb][0].y = pk2(p[mb][2], p[mb][3]); pw[mb][0].z = pk2(p[mb][4], p[mb][5]); pw[mb][0].w = pk2(p[mb][6], p[mb][7]);
            pw[mb][1].x = pk2(p[mb][8], p[mb][9]); pw[mb][1].y = pk2(p[mb][10], p[mb][11]); pw[mb][1].z = pk2(p[mb][12], p[mb][13]); pw[mb][1].w = pk2(p[mb][14], p[mb][15]); }
        lsum += __shfl_xor(lsum, 32);
        const float rl = 1.0f / lsum;
        asm volatile("s_waitcnt vmcnt(0)" ::: "memory"); __syncthreads();
        bf16_t* orow = OX + (size_t)(tokw + r32) * DM + h * 256 + 4 * hi;
#pragma unroll 1
        for (int db = 0; db < 8; ++db) { f32x16 o = {};
#pragma unroll
            for (int mb = 0; mb < 8; ++mb)
#pragma unroll
                for (int k2 = 0; k2 < 2; ++k2) { const unsigned char* vp = vfb + 16 * 1040 * db + 64 * mb + 32 * k2;
                    const s16x4 lo = *(const s16x4*)vp, hi4 = *(const s16x4*)(vp + 16); const bf16x8 vf = {lo[0], lo[1], lo[2], lo[3], hi4[0], hi4[1], hi4[2], hi4[3]};
                    o = __builtin_amdgcn_mfma_f32_32x32x16_bf16(vf, __builtin_bit_cast(bf16x8, pw[mb][k2]), o, 0, 0, 0); }
#pragma unroll
            for (int rq = 0; rq < 4; ++rq) { u32x2 w; w.x = pk2(o[rq * 4] * rl, o[rq * 4 + 1] * rl); w.y = pk2(o[rq * 4 + 2] * rl, o[rq * 4 + 3] * rl); *(u32x2*)(orow + db * 32 + 8 * rq) = w; } }
        asm volatile("s_waitcnt lgkmcnt(0)" ::: "memory"); __syncthreads();
    }
}

__device__ __forceinline__ bool static_unit(int M, int N, int G, int c, int i, int& pm, int& pn) {
    const int nM = M / 256, nN = N / 256, nwg = nM * nN; const long L = (long)i * G + c; if (L >= nwg) return false;
    int wgid = (int)L; { const int q = nwg / 8, r = nwg % 8, xcd = wgid % 8, off = wgid / 8; wgid = (xcd < r ? xcd * (q + 1) : r * (q + 1) + (xcd - r) * q) + off; }
    const int nig = 8 * nN, gid = wgid / nig, fm = gid * 8, gsz = (nM - fm) < 8 ? (nM - fm) : 8;
    pm = fm + ((wgid % nig) % gsz); pn = (wgid % nig) / gsz; return true;
}
__device__ __forceinline__ void rstd_prepass(const float* SS, int N, int G, int c, unsigned char* lds) {
    int tid_l = threadIdx.x; asm volatile("" : "+v"(tid_l)); const int tid = tid_l, row = tid >> 1, half = tid & 1;
    float* RS = (float*)(lds + 131072);
    f32x4 a[6], b[6]; bool ok[6];
#pragma unroll
    for (int i = 0; i < 6; ++i) { int pm = 0, pn = 0; ok[i] = static_unit(T, N, G, c, i, pm, pn);
        if (ok[i]) { const f32x4* p = (const f32x4*)(SS + (size_t)(pm * 256 + row) * 16 + half * 8); a[i] = p[0]; b[i] = p[1]; } else { a[i] = (f32x4){0.f, 0.f, 0.f, 0.f}; b[i] = a[i]; } }
#pragma unroll
    for (int i = 0; i < 6; ++i) { float s = ((a[i][0] + a[i][1]) + (a[i][2] + a[i][3])) + ((b[i][0] + b[i][1]) + (b[i][2] + b[i][3])); s += __shfl_xor(s, 1);
        if (ok[i] && half == 0) RS[i * 256 + row] = __builtin_amdgcn_rsqf(s * (1.0f / 1024.0f) + 1e-6f); }
    __syncthreads();
}
__global__ void __launch_bounds__(NTHR, 2) hybrid_fwd(Params Parg) {
    KP P = (KP)__builtin_amdgcn_kernarg_segment_ptr();
    extern __shared__ __attribute__((aligned(16))) unsigned char lds[];
    cg::grid_group grid = cg::this_grid();
    const int tid = threadIdx.x, lane = tid & 63, wave = __builtin_amdgcn_readfirstlane(tid >> 6);
    const int G = gridDim.x, bx = blockIdx.x, vcu = (G % 8 == 0) ? (bx % 8) * (G / 8) + bx / 8 : bx;
    const int gw = vcu * NWAVES + wave, ngw = G * NWAVES;
    unsigned char* ws = P->ws;
    bf16_t* XN = (bf16_t*)(ws + WS_XN); bf16_t* H = (bf16_t*)(ws + WS_H); bf16_t* HM = (bf16_t*)(ws + WS_H); bf16_t* Y = (bf16_t*)(ws + WS_Y);
    PG8_LAS unsigned char* lds3 = (PG8_LAS unsigned char*)lds;
    if (tid < 16) ((volatile unsigned*)(lds + MISC_OFF))[tid] = 0u;
    __syncthreads();
    (void)xcd_barrier_post((unsigned*)(ws + WS_CTL), (volatile LAS unsigned*)(lds3 + MISC_OFF));
#define GSYNC() do { XcdBarrier b_; b_.bar = (unsigned*)(P->ws + WS_CTL); b_.x = xb_xcc_id(); b_.st = (volatile LAS unsigned*)(lds3 + MISC_OFF); xcd_barrier(b_); } while (0)
#define TAILCONV(first_, count_) do { if (G == 256) { if (bx >= 128) convert_items(P, lds, (first_), (count_), bx - 128, 128); } else convert_items(P, lds, (first_), (count_), bx, G); } while (0)
#define WPTR(l, off) ((bf16_t*)(ws + WS_W + (size_t)(l) * W_LAYER + (off)))

    if (PHM & 512) {
        convert_items(P, lds, 0, 2816, vcu, G);
        rope_table((f32x2*)(ws + WS_ROPE), vcu * NTHR + tid, G * NTHR);
        for (int l = 0; l < 2; ++l) norm_rows(P->in[I_MEM], P->in[I_MN] + l * DM, (bf16_t*)(ws + WS_MEMN) + (size_t)l * 512 * DM, 512, vcu, G);
        xb_rows(P->in[I_X], XN, (float*)(ws + WS_SS), T, vcu, G);
    }
    if (G > (1 << 20)) grid.sync();
    GSYNC();
    for (int l = 0; l < 2; ++l) {
        const float* xin = (l == 0) ? P->in[I_X] : P->out;
        {   pg8::Gemm g{XN, WPTR(l, O_W13A), T, 2 * FF, DM}; pg8::StaticOrder S; S.init(T, 2 * FF, G, bx); rstd_prepass((const float*)(ws + WS_SS), 2 * FF, G, bx, lds); pg8::EpiSwiGLU E{H, FF, (const PG8_LAS float*)(lds3 + 131072), 0};
            pg8::gemm_phase<pg8::EpiSwiGLU, pg8::StaticOrder, true, true>(lds3, g, S, E); }
        { const int lb = l * W_ITEMS_LAYER; TAILCONV(lb + (l ? 4224 : 2816), (l ? 2304 : 3712)); TAILCONV(lb + 7552, 512); }
        if (l == 0) { TAILCONV(6528, 1024); TAILCONV(W_ITEMS_LAYER + 6528, 1024); }
        GSYNC();
        {   pg8::Gemm g{H, WPTR(l, O_W2A), T, DM, FF}; pg8::StaticOrder S; S.init(T, DM, G, bx); pg8::EpiResid E{xin, P->out, DM, 0.5f, XN, (float*)(ws + WS_SS)};
            pg8::gemm_phase<pg8::EpiResid, pg8::StaticOrder, true, true>(lds3, g, S, E); }
        GSYNC();
        {   pg8::Gemm g{XN, WPTR(l, O_WIN), T, NINP, DM}; pg8::StaticOrder S; S.init(T, NINP, G, bx); rstd_prepass((const float*)(ws + WS_SS), NINP, G, bx, lds); pg8::EpiStoreBf16 E{HM, NINP, (float*)(ws + WS_GATES), (const PG8_LAS float*)(lds3 + 131072), 0};
            pg8::gemm_phase<pg8::EpiStoreBf16, pg8::StaticOrder, true, true>(lds3, g, S, E); }
        if (l == 0) {
            if (G == 256) { if (bx >= 128 && bx < 224) convert_items(P, lds, 8064, 4224, bx - 128, 96); } else convert_items(P, lds, 8064, 4224, bx, G);
            for (int l2 = 0; l2 < 2; ++l2) {
                pg8::Gemm g{(const bf16_t*)(ws + WS_MEMN) + (size_t)l2 * 512 * DM, WPTR(l2, O_WKV), 512, 2 * DM, DM}; pg8::StaticOrder S; S.init(512, 2 * DM, G, (bx + 240 * G - 224 - l2 * 16) % G);
                pg8::EpiF32 E{(float*)(ws + WS_KVRAW) + (size_t)l2 * 512 * 2048, 2048};
                pg8::gemm_phase<pg8::EpiF32, pg8::StaticOrder, true, true>(lds3, g, S, E); }
        } else TAILCONV(l * W_ITEMS_LAYER + 8064, 4224);
        GSYNC();
        if (l == 0) memprep(P, vcu, G);
        if (PHM & 2) conv_phase(P, l, lds, vcu, G);
        if (PHM & 4) mlstm_local(P, l, lds, vcu, G);
        GSYNC();
        if (PHM & 8) mlstm_scan(P, vcu, G);
        if (PHM & 16) {
            const attn_body::bf16* Qp = (const attn_body::bf16*)(HM + OFF_Q); const attn_body::bf16* Kp = (const attn_body::bf16*)(HM + OFF_K); const attn_body::bf16* Vp = (const attn_body::bf16*)(HM + OFF_V);
            bool nomax;
            {   const float gq = wave_max(fabsf(P->in[I_AQN][l * 64 + (threadIdx.x & 63)])), gk = wave_max(fabsf(P->in[I_AKN][l * 64 + (threadIdx.x & 63)]));
                nomax = __builtin_amdgcn_readfirstlane((int)(64.0f * attn_body::C2 * gq * gk * 1.02f <= 48.0f)) != 0; }
#define ATTN_UNIT(b_, h_, qb_) do { if (nomax) attn_body::attn_unit<8, true>((b_), (h_), (qb_), Qp, Kp, Vp, (attn_body::bf16*)Y, (char*)lds, P->in[I_AQN] + l * 64, (const float*)(P->ws + WS_ROPE)); \
                                    else attn_body::attn_unit<8, false>((b_), (h_), (qb_), Qp, Kp, Vp, (attn_body::bf16*)Y, (char*)lds, P->in[I_AQN] + l * 64, (const float*)(P->ws + WS_ROPE)); } while (0)
            __syncthreads();
            if (G == 256) { const int xcd = vcu >> 5, local = vcu & 31, pair = xcd >> 1;
                for (int i = 0; i < 2; ++i) { const int idx = (xcd & 1) * 64 + local * 2 + i; ATTN_UNIT(pair >> 1, (pair & 1) * 4 + (idx >> 5), idx & 31); } }
            else for (int u = vcu; u < 512; u += G) { const int pair = u >> 7, idx = u & 127; ATTN_UNIT(pair >> 1, (pair & 1) * 4 + (idx >> 5), idx & 31); }
            asm volatile("s_waitcnt vmcnt(0)" ::: "memory"); __syncthreads();
        }
        GSYNC();
        if (PHM & 32) mlstm_out(P, l, lds, vcu, G);
        GSYNC();
        {   pg8::Gemm g{Y, WPTR(l, O_WOUT), T, DM, DM}; pg8::StaticOrder S; S.init(T, DM, G, bx); pg8::EpiResid E{P->out, P->out, DM, 1.0f, XN, (float*)(ws + WS_SS)};
            pg8::gemm_phase<pg8::EpiResid, pg8::StaticOrder, true, true>(lds3, g, S, E); }
        GSYNC();
        {   pg8::Gemm g{XN, WPTR(l, O_WQ), T, DM, DM}; pg8::StaticOrder S; S.init(T, DM, G, bx); rstd_prepass((const float*)(ws + WS_SS), DM, G, bx, lds); pg8::EpiStoreBf16 E{(bf16_t*)(ws + WS_QX), DM, nullptr, (const PG8_LAS float*)(lds3 + 131072), 0};
            pg8::gemm_phase<pg8::EpiStoreBf16, pg8::StaticOrder, true, true>(lds3, g, S, E); }
        {
            int xu = -1;
            if (G == 256) {
                const int nwg = 256, q8 = nwg / 8; int wgid = bx; wgid = (wgid % 8) * q8 + wgid / 8;
                const int nig = 8 * 4, gid = wgid / nig, fm = gid * 8; const int upm = fm + ((wgid % nig) % 8), upn = (wgid % nig) / 8;
                xu = __builtin_amdgcn_readfirstlane(((upm >> 5) << 7) | (upn << 5) | (upm & 31)); }
            else GSYNC();
            xattn_phase(P, l, lds, vcu, G, xu); }
        GSYNC();
        {   pg8::Gemm g{(const bf16_t*)(ws + WS_OX), WPTR(l, O_WO), T, DM, DM}; pg8::StaticOrder S; S.init(T, DM, G, bx); pg8::EpiResid E{P->out, P->out, DM, 1.0f, XN, (float*)(ws + WS_SS)};
            pg8::gemm_phase<pg8::EpiResid, pg8::StaticOrder, true, true>(lds3, g, S, E); }
        GSYNC();
        {   pg8::Gemm g{XN, WPTR(l, O_W13B), T, 2 * FF, DM}; pg8::StaticOrder S; S.init(T, 2 * FF, G, bx); rstd_prepass((const float*)(ws + WS_SS), 2 * FF, G, bx, lds); pg8::EpiSwiGLU E{H, FF, (const PG8_LAS float*)(lds3 + 131072), 0};
            pg8::gemm_phase<pg8::EpiSwiGLU, pg8::StaticOrder, true, true>(lds3, g, S, E); }
        if (l == 0) TAILCONV(W_ITEMS_LAYER, 2816 + 1408);
        GSYNC();
        {   pg8::Gemm g{H, WPTR(l, O_W2B), T, DM, FF}; pg8::StaticOrder S; S.init(T, DM, G, bx); pg8::EpiResid E{P->out, P->out, DM, 0.5f, XN, (float*)(ws + WS_SS)};
            pg8::gemm_phase<pg8::EpiResid, pg8::StaticOrder, true, true>(lds3, g, S, E); }
        if (l == 0) GSYNC();
    }
}
}

extern "C" void kernel_launch(void* const* d_in, const int* in_sizes, int n_in, void* d_out, int out_size, void* d_ws, size_t ws_size, hipStream_t stream) {
    static int grid = 0;
    if (grid == 0) {
        if (n_in != 26 || ws_size < mk::WS_TOTAL) { fprintf(stderr, "kernel_launch: expected 26 inputs and >= %zu bytes of workspace (got %d, %zu)\n", (size_t)mk::WS_TOTAL, n_in, ws_size); grid = -1; return; }
        int dev = 0, cus = 0, per_cu = 0;
        hipGetDevice(&dev); hipDeviceGetAttribute(&cus, hipDeviceAttributeMultiprocessorCount, dev);
        if (hipFuncSetAttribute((const void*)mk::hybrid_fwd, hipFuncAttributeMaxDynamicSharedMemorySize, mk::LDS_BYTES) != hipSuccess) { fprintf(stderr, "kernel_launch: hipFuncSetAttribute failed\n"); grid = -1; return; }
        if (hipOccupancyMaxActiveBlocksPerMultiprocessor(&per_cu, (const void*)mk::hybrid_fwd, mk::NTHR, mk::LDS_BYTES) != hipSuccess || per_cu < 1) { fprintf(stderr, "kernel_launch: occupancy query says %d blocks per CU\n", per_cu); (void)hipGetLastError(); per_cu = 1; }
        grid = cus * (per_cu > 1 ? 1 : per_cu);
    }
    if (grid < 0) return;
    if (hipMemsetAsync((char*)d_ws + mk::WS_CTL, 0, mk::CTL_BYTES, stream) != hipSuccess) { fprintf(stderr, "kernel_launch: memset of the barrier words failed\n"); return; }
    mk::Params p{};
    for (int i = 0; i < 26; ++i) p.in[i] = (const float*)d_in[i];
    p.out = (float*)d_out; p.ws = (unsigned char*)d_ws;
    void* args[] = {&p};
    hipError_t e = hipLaunchCooperativeKernel((const void*)mk::hybrid_fwd, dim3(grid), dim3(mk::NTHR), args, mk::LDS_BYTES, stream);
    if (e != hipSuccess) fprintf(stderr, "kernel_launch: cooperative launch failed: %s (grid %d)\n", hipGetErrorString(e), grid);
}
```
